# Optimizing an MI355X kernel written in HIP

```python
import math
import jax
import jax.numpy as jnp
from jax import lax
import numpy as np

D_MODEL = 1024
BATCH = 8
SEQ = 2048
DEPTH = 4

GRID_W = 64
CTX_LEN = 256
N_MIXERS = 4
N_MOD = 9
D_FF = 2816
ROPE_THETA = 10000.0
Q_BLOCK = 128
NEG_INF = -1e30
EPS = 1e-6

DA_HEAD_DIM = 64
DA_HEADS = D_MODEL // (2 * DA_HEAD_DIM)
GQA_HEAD_DIM = 64
GQA_HEADS = D_MODEL // GQA_HEAD_DIM
GQA_KV_HEADS = 4
GQA_GROUP = GQA_HEADS // GQA_KV_HEADS
MLA_HEADS = 16
MLA_Q_LORA = 256
MLA_KV_LORA = 128
MLA_NOPE = 64
MLA_ROPE = 32
MLA_V = 64
NA_HEAD_DIM = 64
NA_HEADS = D_MODEL // NA_HEAD_DIM
NA_WIN_ROWS = 8
NA_WIN_COLS = 16

kernel_name = "hybrid_diffusion_trunk_prefix_ctx"


def rms_norm(x, g):
    xf = x.astype(jnp.float32)
    y = xf * lax.rsqrt(jnp.mean(xf * xf, axis=-1, keepdims=True) + EPS)
    return (y * g.astype(jnp.float32)).astype(x.dtype)


def modulate(x, g, shift, scale):
    return rms_norm(x, g) * (1 + scale) + shift


def swiglu(h, w_in, w_out):
    gate, up = jnp.split(h @ w_in, 2, axis=-1)
    return (jax.nn.silu(gate) * up) @ w_out


def axial_rope(x, row, col):
    rd = x.shape[-1]
    half = rd // 2
    nf = half // 2
    inv_freq = ROPE_THETA ** (-jnp.arange(nf, dtype=jnp.float32) / nf)

    def rot(xh, pos):
        ang = pos.astype(jnp.float32)[:, None] * inv_freq
        shape = (ang.shape[0],) + (1,) * (x.ndim - 3) + (nf,)
        cos = jnp.cos(ang).reshape(shape).astype(x.dtype)
        sin = jnp.sin(ang).reshape(shape).astype(x.dtype)
        x1, x2 = jnp.split(xh, 2, axis=-1)
        return jnp.concatenate([x1 * cos - x2 * sin, x1 * sin + x2 * cos], axis=-1)

    return jnp.concatenate([rot(x[..., :half], row), rot(x[..., half:], col)], axis=-1)


def sweep_query_blocks(attend, q):
    b, l = q.shape[:2]
    nb = l // Q_BLOCK
    qb = jnp.moveaxis(q.reshape((b, nb, Q_BLOCK) + q.shape[2:]), 1, 0)
    out = lax.map(attend, qb)
    return jnp.moveaxis(out, 0, 1).reshape((b, l) + out.shape[3:])


def gqa_attend(q, k, v, scale):
    s = jnp.einsum("bqhgd,bkhd->bhgqk", q, k).astype(jnp.float32) * scale
    p = jax.nn.softmax(s, axis=-1).astype(v.dtype)
    return jnp.einsum("bhgqk,bkhd->bqhgd", p, v)


def _da_project(t, w_qkv):
    bt, lt, _ = t.shape
    q, k, v = jnp.split(t @ w_qkv, 3, axis=-1)
    q = q.reshape(bt, lt, DA_HEADS, 2, DA_HEAD_DIM)
    k = k.reshape(bt, lt, DA_HEADS, 2, DA_HEAD_DIM)
    v = v.reshape(bt, lt, DA_HEADS, 2 * DA_HEAD_DIM)
    return q, k, v


def _diff_attend(q, k, v, lam):
    s = jnp.einsum("bqhmd,bkhmd->bhmqk", q, k).astype(jnp.float32) * DA_HEAD_DIM ** -0.5
    p = jax.nn.softmax(s, axis=-1)
    p = (p[:, :, 0] - lam * p[:, :, 1]).astype(v.dtype)
    return jnp.einsum("bhqk,bkhe->bqhe", p, v)


def diff_attention(h, hc, w_qkv, lam_q1, lam_k1, lam_q2, lam_k2, subln_g, w_o, layer_idx, row, col, with_ctx):
    b, l, _ = h.shape
    lam_init = 0.8 - 0.6 * math.exp(-0.3 * layer_idx)
    lam = (jnp.exp(jnp.sum(lam_q1 * lam_k1).astype(jnp.float32))
           - jnp.exp(jnp.sum(lam_q2 * lam_k2).astype(jnp.float32)) + lam_init)
    q, k, v = _da_project(h, w_qkv)
    qc, kc, vc = _da_project(hc, w_qkv)
    q = axial_rope(q, row, col)
    k = axial_rope(k, row, col)
    k_all = jnp.concatenate([k, kc], axis=1)
    v_all = jnp.concatenate([v, vc], axis=1)

    def finish(o):
        o = rms_norm(o, subln_g) * (1 - lam_init)
        return o.reshape(o.shape[0], o.shape[1], -1) @ w_o

    y = finish(sweep_query_blocks(lambda qb: _diff_attend(qb, k_all, v_all, lam), q))
    yc = finish(_diff_attend(qc, kc, vc, lam)) if with_ctx else None
    return y, yc


def _gqa_project(t, w_qkv, q_norm_g, k_norm_g):
    bt, lt, _ = t.shape
    q, k, v = jnp.split(t @ w_qkv, [GQA_HEADS * GQA_HEAD_DIM, (GQA_HEADS + GQA_KV_HEADS) * GQA_HEAD_DIM], axis=-1)
    q = rms_norm(q.reshape(bt, lt, GQA_KV_HEADS, GQA_GROUP, GQA_HEAD_DIM), q_norm_g)
    k = rms_norm(k.reshape(bt, lt, GQA_KV_HEADS, GQA_HEAD_DIM), k_norm_g)
    v = v.reshape(bt, lt, GQA_KV_HEADS, GQA_HEAD_DIM)
    return q, k, v


def gqa_attention(h, hc, w_qkv, q_norm_g, k_norm_g, w_o, row, col, with_ctx):
    scale = GQA_HEAD_DIM ** -0.5
    q, k, v = _gqa_project(h, w_qkv, q_norm_g, k_norm_g)
    qc, kc, vc = _gqa_project(hc, w_qkv, q_norm_g, k_norm_g)
    q = axial_rope(q, row, col)
    k = axial_rope(k, row, col)
    k_all = jnp.concatenate([k, kc], axis=1)
    v_all = jnp.concatenate([v, vc], axis=1)
    o = sweep_query_blocks(lambda qb: gqa_attend(qb, k_all, v_all, scale), q)
    y = o.reshape(o.shape[0], o.shape[1], -1) @ w_o
    yc = None
    if with_ctx:
        oc = gqa_attend(qc, kc, vc, scale)
        yc = oc.reshape(oc.shape[0], oc.shape[1], -1) @ w_o
    return y, yc


def _mla_project(t, w_down, q_norm_g, kv_norm_g, w_uq, w_ukv, row, col):
    bt, lt, _ = t.shape
    cq, ckv, k_pe = jnp.split(t @ w_down, [MLA_Q_LORA, MLA_Q_LORA + MLA_KV_LORA], axis=-1)
    q = (rms_norm(cq, q_norm_g) @ w_uq).reshape(bt, lt, MLA_HEADS, MLA_NOPE + MLA_ROPE)
    kv = (rms_norm(ckv, kv_norm_g) @ w_ukv).reshape(bt, lt, MLA_HEADS, MLA_NOPE + MLA_V)
    q_nope, q_pe = jnp.split(q, [MLA_NOPE], axis=-1)
    k_nope, v = jnp.split(kv, [MLA_NOPE], axis=-1)
    k_pe = k_pe[:, :, None, :]
    if row is not None:
        q_pe = axial_rope(q_pe, row, col)
        k_pe = axial_rope(k_pe, row, col)
    q = jnp.concatenate([q_nope, q_pe], axis=-1)[:, :, :, None, :]
    k = jnp.concatenate([k_nope, jnp.broadcast_to(k_pe, (bt, lt, MLA_HEADS, MLA_ROPE))], axis=-1)
    return q, k, v


def mla_attention(h, hc, w_down, q_norm_g, kv_norm_g, w_uq, w_ukv, w_o, row, col, with_ctx):
    scale = (MLA_NOPE + MLA_ROPE) ** -0.5
    q, k, v = _mla_project(h, w_down, q_norm_g, kv_norm_g, w_uq, w_ukv, row, col)
    qc, kc, vc = _mla_project(hc, w_down, q_norm_g, kv_norm_g, w_uq, w_ukv, None, None)
    k_all = jnp.concatenate([k, kc], axis=1)
    v_all = jnp.concatenate([v, vc], axis=1)
    o = sweep_query_blocks(lambda qb: gqa_attend(qb, k_all, v_all, scale), q)
    y = o.reshape(o.shape[0], o.shape[1], -1) @ w_o
    yc = None
    if with_ctx:
        oc = gqa_attend(qc, kc, vc, scale)
        yc = oc.reshape(oc.shape[0], oc.shape[1], -1) @ w_o
    return y, yc


def _na_project(t, w_qkv):
    bt, lt, _ = t.shape
    q, k, v = jnp.split(t @ w_qkv, 3, axis=-1)
    shp = (bt, lt, NA_HEADS, NA_HEAD_DIM)
    return q.reshape(shp), k.reshape(shp), v.reshape(shp)


def neighbourhood_attention(h, hc, w_qkv, rpb, w_o, with_ctx):
    b, l, _ = h.shape
    rows = l // GRID_W
    wr = min(NA_WIN_ROWS, rows)
    scale = NA_HEAD_DIM ** -0.5
    q, k, v = _na_project(h, w_qkv)
    qc, kc, vc = _na_project(hc, w_qkv)
    q = q.reshape(b, rows, GRID_W, NA_HEADS, NA_HEAD_DIM)
    k = k.reshape(b, rows, GRID_W, NA_HEADS, NA_HEAD_DIM)
    v = v.reshape(b, rows, GRID_W, NA_HEADS, NA_HEAD_DIM)

    cols = jnp.arange(GRID_W)
    col_start = jnp.clip(cols - NA_WIN_COLS // 2, 0, GRID_W - NA_WIN_COLS)
    col_in = (cols[None, :] >= col_start[:, None]) & (cols[None, :] < col_start[:, None] + NA_WIN_COLS)
    col_idx = jnp.clip(cols[None, :] - cols[:, None] + NA_WIN_COLS - 1, 0, 2 * NA_WIN_COLS - 2)
    row_ids = jnp.arange(rows)
    row_start = jnp.clip(row_ids - wr // 2, 0, rows - wr)

    def attend_row(args):
        q_r, r, rs = args
        k_band = lax.dynamic_slice_in_dim(k, rs, wr, axis=1)
        v_band = lax.dynamic_slice_in_dim(v, rs, wr, axis=1)
        row_idx = rs + jnp.arange(wr) - r + (NA_WIN_ROWS - 1)
        bias = jnp.transpose(rpb[:, row_idx][:, :, col_idx], (0, 2, 1, 3)).astype(jnp.float32)
        s_nb = jnp.einsum("bqhd,bjkhd->bhqjk", q_r, k_band).astype(jnp.float32) * scale + bias
        s_nb = jnp.where(col_in[:, None, :], s_nb, NEG_INF).reshape(b, NA_HEADS, GRID_W, wr * GRID_W)
        s_cx = jnp.einsum("bqhd,bchd->bhqc", q_r, kc).astype(jnp.float32) * scale
        p = jax.nn.softmax(jnp.concatenate([s_nb, s_cx], axis=-1), axis=-1).astype(v.dtype)
        p_nb = p[..., :wr * GRID_W].reshape(b, NA_HEADS, GRID_W, wr, GRID_W)
        p_cx = p[..., wr * GRID_W:]
        return (jnp.einsum("bhqjk,bjkhd->bqhd", p_nb, v_band)
                + jnp.einsum("bhqc,bchd->bqhd", p_cx, vc))

    o = lax.map(attend_row, (jnp.moveaxis(q, 1, 0), row_ids, row_start))
    y = jnp.moveaxis(o, 0, 1).reshape(b, l, NA_HEADS * NA_HEAD_DIM) @ w_o
    yc = None
    if with_ctx:
        oc = gqa_attend(qc[:, :, :, None, :], kc, vc, scale)
        yc = oc.reshape(oc.shape[0], oc.shape[1], -1) @ w_o
    return y, yc


def setup_inputs(seed: int = 0) -> dict:
    key = jax.random.key(seed)
    keys = iter(jax.random.split(key, 32))
    f32 = jnp.float32
    D = D_MODEL

    def normal(shape, std):
        return jax.random.normal(next(keys), shape, f32) * std

    def gain(shape):
        return 1.0 + normal(shape, 0.05)

    n_a, n_b, n_c, n_d = [len(range(m, DEPTH, N_MIXERS)) for m in range(N_MIXERS)]
    da_width = DA_HEADS * 2 * DA_HEAD_DIM
    gqa_width = GQA_HEADS * GQA_HEAD_DIM
    na_width = NA_HEADS * NA_HEAD_DIM
    return {
        "x": normal((BATCH, SEQ, D), 1.0),
        "c": normal((BATCH, D), 1.0),
        "ctx": normal((BATCH, CTX_LEN, D), 1.0),
        "c_ctx": normal((D,), 1.0),
        "w_mod": normal((DEPTH, D, N_MOD * D), 0.5 * D ** -0.5),
        "b_mod": normal((DEPTH, N_MOD * D), 0.02),
        "norm_g": gain((DEPTH, 3, D)),
        "w_ffn_in": normal((DEPTH, 2, D, 2 * D_FF), D ** -0.5),
        "w_ffn_out": normal((DEPTH, 2, D_FF, D), D_FF ** -0.5),
        "da_w_qkv": normal((n_a, D, 3 * da_width), D ** -0.5),
        "da_lam_q1": normal((n_a, DA_HEAD_DIM), 0.1),
        "da_lam_k1": normal((n_a, DA_HEAD_DIM), 0.1),
        "da_lam_q2": normal((n_a, DA_HEAD_DIM), 0.1),
        "da_lam_k2": normal((n_a, DA_HEAD_DIM), 0.1),
        "da_subln_g": gain((n_a, 2 * DA_HEAD_DIM)),
        "da_w_o": normal((n_a, da_width, D), da_width ** -0.5),
        "gqa_w_qkv": normal((n_b, D, (GQA_HEADS + 2 * GQA_KV_HEADS) * GQA_HEAD_DIM), D ** -0.5),
        "gqa_q_norm_g": gain((n_b, GQA_HEAD_DIM)),
        "gqa_k_norm_g": gain((n_b, GQA_HEAD_DIM)),
        "gqa_w_o": normal((n_b, gqa_width, D), gqa_width ** -0.5),
        "mla_w_down": normal((n_c, D, MLA_Q_LORA + MLA_KV_LORA + MLA_ROPE), D ** -0.5),
        "mla_q_norm_g": gain((n_c, MLA_Q_LORA)),
        "mla_kv_norm_g": gain((n_c, MLA_KV_LORA)),
        "mla_w_uq": normal((n_c, MLA_Q_LORA, MLA_HEADS * (MLA_NOPE + MLA_ROPE)), MLA_Q_LORA ** -0.5),
        "mla_w_ukv": normal((n_c, MLA_KV_LORA, MLA_HEADS * (MLA_NOPE + MLA_V)), MLA_KV_LORA ** -0.5),
        "mla_w_o": normal((n_c, MLA_HEADS * MLA_V, D), (MLA_HEADS * MLA_V) ** -0.5),
        "na_w_qkv": normal((n_d, D, 3 * na_width), D ** -0.5),
        "na_rpb": normal((n_d, NA_HEADS, 2 * NA_WIN_ROWS - 1, 2 * NA_WIN_COLS - 1), 0.1),
        "na_w_o": normal((n_d, na_width, D), na_width ** -0.5),
        "final_g": gain((D,)),
    }


def reference(x, c, ctx, c_ctx, w_mod, b_mod, norm_g, w_ffn_in, w_ffn_out,
              da_w_qkv, da_lam_q1, da_lam_k1, da_lam_q2, da_lam_k2, da_subln_g, da_w_o,
              gqa_w_qkv, gqa_q_norm_g, gqa_k_norm_g, gqa_w_o,
              mla_w_down, mla_q_norm_g, mla_kv_norm_g, mla_w_uq, mla_w_ukv, mla_w_o,
              na_w_qkv, na_rpb, na_w_o, final_g):
    b, l, d = x.shape
    t = jnp.arange(l)
    row = t // GRID_W
    col = t % GRID_W
    silu_c = jax.nn.silu(c)
    silu_cc = jax.nn.silu(c_ctx)
    xc = ctx
    for i in range(DEPTH):
        kind, inst = i % N_MIXERS, i // N_MIXERS
        with_ctx = i < DEPTH - 1
        mod = (silu_c @ w_mod[i] + b_mod[i]).reshape(b, N_MOD, 1, d)
        mod_c = (silu_cc @ w_mod[i] + b_mod[i]).reshape(N_MOD, d)

        x = x + 0.5 * mod[:, 2] * swiglu(modulate(x, norm_g[i, 0], mod[:, 0], mod[:, 1]), w_ffn_in[i, 0], w_ffn_out[i, 0])
        xc = xc + 0.5 * mod_c[2] * swiglu(modulate(xc, norm_g[i, 0], mod_c[0], mod_c[1]), w_ffn_in[i, 0], w_ffn_out[i, 0])

        h = modulate(x, norm_g[i, 1], mod[:, 3], mod[:, 4])
        hc = modulate(xc, norm_g[i, 1], mod_c[3], mod_c[4])
        if kind == 0:
            y, yc = diff_attention(h, hc, da_w_qkv[inst], da_lam_q1[inst], da_lam_k1[inst], da_lam_q2[inst],
                                   da_lam_k2[inst], da_subln_g[inst], da_w_o[inst], i, row, col, with_ctx)
        elif kind == 1:
            y, yc = gqa_attention(h, hc, gqa_w_qkv[inst], gqa_q_norm_g[inst], gqa_k_norm_g[inst], gqa_w_o[inst],
                                  row, col, with_ctx)
        elif kind == 2:
            y, yc = mla_attention(h, hc, mla_w_down[inst], mla_q_norm_g[inst], mla_kv_norm_g[inst], mla_w_uq[inst],
                                  mla_w_ukv[inst], mla_w_o[inst], row, col, with_ctx)
        else:
            y, yc = neighbourhood_attention(h, hc, na_w_qkv[inst], na_rpb[inst], na_w_o[inst], with_ctx)
        x = x + mod[:, 5] * y

        x = x + 0.5 * mod[:, 8] * swiglu(modulate(x, norm_g[i, 2], mod[:, 6], mod[:, 7]), w_ffn_in[i, 1], w_ffn_out[i, 1])
        if with_ctx:
            xc = xc + mod_c[5] * yc
            xc = xc + 0.5 * mod_c[8] * swiglu(modulate(xc, norm_g[i, 2], mod_c[6], mod_c[7]), w_ffn_in[i, 1], w_ffn_out[i, 1])
    return rms_norm(x, final_g)
```

```cpp
#include <hip/hip_runtime.h>
#include <hip/hip_cooperative_groups.h>
#include <cstdio>
#include <cstdint>
namespace cg = cooperative_groups;
namespace pg8 {
#define PG8_LAS __attribute__((address_space(3)))
typedef unsigned short bf16_t;
typedef short bf16x8 __attribute__((ext_vector_type(8)));
typedef float f32x4 __attribute__((ext_vector_type(4)));
typedef unsigned u32x4 __attribute__((ext_vector_type(4)));
constexpr int BM = 256, BK = 64, HALF = 128, HTB = HALF * BK * 2  , STAGE_BYTES = 8 * HTB, NXCD = 8, WGM = 8;

__host__ __device__ __forceinline__ int lds_byte(int r, int c) { const int st = (r >> 4) * 2 + (c >> 5), rr = r & 15, cc = c & 31, ob = rr * 64 + cc * 2; return st * 1024 + (ob ^ (((ob >> 9) & 1) << 5)); }
__host__ __device__ __forceinline__ void stage_rc(int b, int& R, int& C) { const int st = b / 1024, sb = b % 1024, swz = sb ^ (((sb >> 9) & 1) << 5); R = (st >> 1) * 16 + swz / 64; C = (st & 1) * 32 + (swz % 64) / 2; }
__host__ __device__ __forceinline__ int perm32(int rho) { const int n = rho >> 4, i = rho & 15; return 8 * (i >> 2) + 4 * n + (i & 3); }

struct Unit { int pm, pn; };
struct Gemm { const bf16_t* A; const bf16_t* Bt; int M, N, K; };

struct StaticOrder {
    int nM, nN, nwg, G, c;
    __host__ __device__ void init(int M, int N, int G_, int c_) { nM = M / BM; nN = N / BM; nwg = nM * nN; G = G_; c = c_; }
    __host__ __device__ bool next(int i, Unit& u) const {
        const long L = (long)i * G + c; if (L >= nwg) return false;
        int wgid = (int)L; { const int q = nwg / NXCD, r = nwg % NXCD, xcd = wgid % NXCD, off = wgid / NXCD; wgid = (xcd < r ? xcd * (q + 1) : r * (q + 1) + (xcd - r) * q) + off; }
        const int nig = WGM * nN, gid = wgid / nig, fm = gid * WGM, gsz = (nM - fm) < WGM ? (nM - fm) : WGM;
        u.pm = fm + ((wgid % nig) % gsz); u.pn = (wgid % nig) / gsz; return true;
    }
    __device__ __forceinline__ void a_ready(const Unit&) const {}
    __device__ __forceinline__ void done(const Unit&) const {}
};

__device__ __forceinline__ unsigned cvt_pk_bf16(float lo, float hi) { unsigned r; asm volatile("v_cvt_pk_bf16_f32 %0, %1, %2" : "=v"(r) : "v"(lo), "v"(hi)); return r; }
typedef float f32x2 __attribute__((ext_vector_type(2)));
template <class Epi, class Sched, bool ALIGN_EPI = false, bool SP2 = false>
__device__ __forceinline__ void gemm_phase(PG8_LAS unsigned char* lds, const Gemm g, const Sched& S, const Epi& E) {
    int tid_l = threadIdx.x; asm volatile("" : "+v"(tid_l));
    const int tid = tid_l, wid = __builtin_amdgcn_readfirstlane(tid >> 6), lane = tid & 63, wr = wid >> 2, wc = wid & 3, fr = lane & 15, fq = lane >> 4;
    const int K = g.K, nt = K / BK;
    unsigned voffA[2], voffB[2];
#pragma unroll
    for (int i = 0; i < 2; ++i) { int R, C; stage_rc(tid * 16 + i * 8192, R, C); const int Rb = Epi::PERM ? ((R & ~31) + perm32(R & 31)) : R;
        voffA[i] = (unsigned)(R * K + C) * 2u; voffB[i] = (unsigned)(Rb * K + C) * 2u; }
    const size_t kstep = (size_t)(BK * 2);
    const size_t hstep = (size_t)HALF * K * 2;
    const size_t tstep = 2 * hstep;
    const unsigned ldsw = (unsigned)wid * 1024u;
    const int aoff = lds_byte(wr * 64 + fr, fq * 8), boff = lds_byte(wc * 32 + fr, fq * 8);
#define PG8_SA(b, h) (((b) * 2 + (h)) * HTB)
#define PG8_SB(b, h) ((4 + (b) * 2 + (h)) * HTB)
#define PG8_STAGE(bufoff, gbase, voff) do { _Pragma("unroll") for (int _i = 0; _i < 2; ++_i) \
        __builtin_amdgcn_global_load_lds((const unsigned*)((const char*)(gbase) + (voff)[_i]), (PG8_LAS unsigned*)(lds + (bufoff) + ldsw + _i * 8192), 16, 0, 0); } while (0)
#define PG8_LDA(dst, b, h) do { _Pragma("unroll") for (int m = 0; m < 4; ++m) _Pragma("unroll") for (int k = 0; k < 2; ++k) dst[m][k] = *(const PG8_LAS bf16x8*)(lds + PG8_SA(b, h) + aoff + m * 2048 + k * 1024); } while (0)
#define PG8_LDB(dst, b, h) do { _Pragma("unroll") for (int n = 0; n < 2; ++n) _Pragma("unroll") for (int k = 0; k < 2; ++k) dst[n][k] = *(const PG8_LAS bf16x8*)(lds + PG8_SB(b, h) + boff + n * 2048 + k * 1024); } while (0)
#define PG8_MMA(ai, bj, At, Bt) do { __builtin_amdgcn_s_setprio(1); _Pragma("unroll") for (int m = 0; m < 4; ++m) _Pragma("unroll") for (int n = 0; n < 2; ++n) _Pragma("unroll") for (int k = 0; k < 2; ++k) \
        acc[ai][bj][m][n] = __builtin_amdgcn_mfma_f32_16x16x32_bf16(Bt[n][k], At[m][k], acc[ai][bj][m][n], 0, 0, 0); __builtin_amdgcn_s_setprio(0); } while (0)
#define PG8_WAIT_V(n) asm volatile("s_waitcnt vmcnt(" #n ")" ::: "memory")
#define PG8_WAIT_L(n) asm volatile("s_waitcnt lgkmcnt(" #n ")" ::: "memory")
#define PG8_BAR __builtin_amdgcn_s_barrier()
#define PG8_SCHED __builtin_amdgcn_sched_barrier(0)
    Unit cur, nxt; int ui = 0;
    if (!S.next(0, cur)) return;
    f32x4 acc[2][2][4][2];
#pragma unroll
    for (int a = 0; a < 2; ++a)
#pragma unroll
        for (int b = 0; b < 2; ++b)
#pragma unroll
            for (int m = 0; m < 4; ++m)
#pragma unroll
                for (int n = 0; n < 2; ++n) acc[a][b][m][n] = (f32x4){0.f, 0.f, 0.f, 0.f};
    bf16x8 At[4][2], B0[2][2], B1[2][2];
    const char* cA = (const char*)g.A + (size_t)cur.pm * tstep; const char* cB = (const char*)g.Bt + (size_t)cur.pn * tstep;
    S.a_ready(cur);
    if constexpr (SP2) {
        PG8_STAGE(PG8_SB(0, 0), cB, voffB); PG8_STAGE(PG8_SB(0, 1), cB + hstep, voffB); PG8_STAGE(PG8_SA(0, 0), cA, voffA); PG8_STAGE(PG8_SA(0, 1), cA + hstep, voffA);
        if (wr == 1) PG8_BAR;
        PG8_WAIT_V(2); PG8_BAR;
        PG8_STAGE(PG8_SB(1, 0), cB + kstep, voffB); PG8_STAGE(PG8_SA(1, 0), cA + kstep, voffA); PG8_STAGE(PG8_SB(1, 1), cB + hstep + kstep, voffB);
        PG8_WAIT_V(6); PG8_BAR;
    } else {
        PG8_STAGE(PG8_SB(0, 0), cB, voffB); PG8_STAGE(PG8_SA(0, 0), cA, voffA); PG8_STAGE(PG8_SB(0, 1), cB + hstep, voffB); PG8_STAGE(PG8_SA(0, 1), cA + hstep, voffA);
        if (wr == 1) PG8_BAR;
        PG8_WAIT_V(4); PG8_BAR;
        PG8_STAGE(PG8_SB(1, 0), cB + kstep, voffB); PG8_STAGE(PG8_SA(1, 0), cA + kstep, voffA); PG8_STAGE(PG8_SB(1, 1), cB + hstep + kstep, voffB);
        PG8_WAIT_V(6); PG8_BAR;
    }
    for (;;) {
        const bool has_next = S.next(ui + 1, nxt);
        const char* nA = has_next ? (const char*)g.A + (size_t)nxt.pm * tstep : cA; const char* nB = has_next ? (const char*)g.Bt + (size_t)nxt.pn * tstep : cB;
        for (int t = 0; t < nt; t += 2) {
            const bool last = (t == nt - 2);
            const char* a1 = cA + (size_t)(t + 1) * kstep;
            const char* a2 = last ? nA : cA + (size_t)(t + 2) * kstep; const char* b2 = last ? nB : cB + (size_t)(t + 2) * kstep;
            const char* a3 = a2 + kstep; const char* b3 = b2 + kstep;
            if (last && has_next) S.a_ready(nxt);
            if constexpr (SP2) {
            PG8_LDB(B0, 0, 0); PG8_LDB(B1, 0, 1); PG8_SCHED; PG8_LDA(At, 0, 0); PG8_STAGE(PG8_SA(1, 1), a1 + hstep, voffA);
            PG8_WAIT_V(8); PG8_WAIT_L(0); PG8_BAR; PG8_MMA(0, 0, At, B0); PG8_MMA(0, 1, At, B1); PG8_BAR; PG8_SCHED;
            PG8_LDA(At, 0, 1); PG8_STAGE(PG8_SB(0, 0), b2, voffB); PG8_STAGE(PG8_SB(0, 1), b2 + hstep, voffB); PG8_STAGE(PG8_SA(0, 0), a2, voffA);
            PG8_WAIT_V(8); PG8_WAIT_L(0); PG8_BAR; PG8_MMA(1, 0, At, B0); PG8_MMA(1, 1, At, B1); PG8_BAR; PG8_SCHED;
            PG8_LDB(B0, 1, 0); PG8_LDB(B1, 1, 1); PG8_SCHED; PG8_LDA(At, 1, 0); PG8_STAGE(PG8_SA(0, 1), a2 + hstep, voffA);
            PG8_WAIT_V(8); PG8_WAIT_L(0); PG8_BAR; PG8_MMA(0, 0, At, B0); PG8_MMA(0, 1, At, B1); PG8_BAR; PG8_SCHED;
            PG8_LDA(At, 1, 1); PG8_STAGE(PG8_SB(1, 0), b3, voffB); PG8_STAGE(PG8_SB(1, 1), b3 + hstep, voffB); PG8_STAGE(PG8_SA(1, 0), a3, voffA);
            PG8_WAIT_V(8); PG8_WAIT_L(0); PG8_BAR; PG8_MMA(1, 0, At, B0); PG8_MMA(1, 1, At, B1); PG8_BAR; PG8_SCHED;
            } else {
            PG8_LDB(B0, 0, 0); PG8_SCHED; PG8_LDA(At, 0, 0); PG8_STAGE(PG8_SA(1, 1), a1 + hstep, voffA);
            PG8_WAIT_L(8); PG8_BAR; PG8_WAIT_L(0); PG8_MMA(0, 0, At, B0); PG8_BAR; PG8_SCHED;
            PG8_LDB(B1, 0, 1); PG8_STAGE(PG8_SB(0, 0), b2, voffB);
            PG8_BAR; PG8_WAIT_L(0); PG8_MMA(0, 1, At, B1); PG8_BAR;
            PG8_LDA(At, 0, 1); PG8_STAGE(PG8_SA(0, 0), a2, voffA);
            PG8_BAR; PG8_WAIT_L(0); PG8_MMA(1, 0, At, B0); PG8_BAR; PG8_SCHED;
            PG8_STAGE(PG8_SB(0, 1), b2 + hstep, voffB);
            PG8_WAIT_V(6); PG8_BAR; PG8_MMA(1, 1, At, B1); PG8_BAR;
            PG8_LDB(B0, 1, 0); PG8_SCHED; PG8_LDA(At, 1, 0); PG8_STAGE(PG8_SA(0, 1), a2 + hstep, voffA);
            PG8_WAIT_L(8); PG8_BAR; PG8_WAIT_L(0); PG8_MMA(0, 0, At, B0); PG8_BAR; PG8_SCHED;
            PG8_LDB(B1, 1, 1); PG8_STAGE(PG8_SB(1, 0), b3, voffB);
            PG8_BAR; PG8_WAIT_L(0); PG8_MMA(0, 1, At, B1); PG8_BAR;
            PG8_LDA(At, 1, 1); PG8_STAGE(PG8_SA(1, 0), a3, voffA);
            PG8_BAR; PG8_WAIT_L(0); PG8_MMA(1, 0, At, B0); PG8_BAR; PG8_SCHED;
            PG8_STAGE(PG8_SB(1, 1), b3 + hstep, voffB);
            PG8_WAIT_V(6); PG8_BAR; PG8_MMA(1, 1, At, B1); PG8_BAR;
            }
        }
        if constexpr (ALIGN_EPI) { if (wr == 0) PG8_BAR; }
        if constexpr (!Epi::AFTER_DRAIN) { E(acc, cur, wr, wc, fr, fq); S.done(cur); }
        if (!has_next) break;
#pragma unroll
        for (int a = 0; a < 2; ++a)
#pragma unroll
            for (int b = 0; b < 2; ++b)
#pragma unroll
                for (int m = 0; m < 4; ++m)
#pragma unroll
                    for (int n = 0; n < 2; ++n) acc[a][b][m][n] = (f32x4){0.f, 0.f, 0.f, 0.f};
        cur = nxt; cA = nA; cB = nB; ++ui;
        if constexpr (ALIGN_EPI) { if (wr == 1) PG8_BAR; }
    }
    PG8_WAIT_V(0);
    if constexpr (!ALIGN_EPI) { if (wr == 0) PG8_BAR; }
    PG8_BAR;
    if constexpr (Epi::AFTER_DRAIN) { E.fused(acc, cur, wr, wc, fr, fq, lds, wid, lane); S.done(cur); }
#undef PG8_SA
#undef PG8_SB
#undef PG8_STAGE
#undef PG8_LDA
#undef PG8_LDB
#undef PG8_MMA
#undef PG8_WAIT_V
#undef PG8_WAIT_L
#undef PG8_BAR
#undef PG8_SCHED
}
}

namespace pg8 {
typedef unsigned u32x2 __attribute__((ext_vector_type(2)));
__device__ __forceinline__ float silu_f(float g) { return g * __builtin_amdgcn_rcpf(1.0f + __builtin_amdgcn_exp2f(-1.4426950408889634f * g)); }
struct EpiSwiGLU {
    static constexpr bool PERM = true, AFTER_DRAIN = false;
    bf16_t* O; int ldc;
    __device__ __forceinline__ void operator()(const f32x4 (&acc)[2][2][4][2], const Unit& u, int wr, int wc, int fr, int fq) const {
        const int row0 = u.pm * BM + wr * 64 + fr, col0 = u.pn * HALF + wc * 32 + 8 * fq;
#pragma unroll
        for (int ai = 0; ai < 2; ++ai)
#pragma unroll
            for (int m = 0; m < 4; ++m) {
                bf16_t* p = O + (size_t)(row0 + ai * HALF + m * 16) * ldc + col0;
                const f32x4 g0 = acc[ai][0][m][0], g1 = acc[ai][0][m][1], u0 = acc[ai][1][m][0], u1 = acc[ai][1][m][1];
                u32x4 w;
                w.x = cvt_pk_bf16(silu_f(g0[0]) * u0[0], silu_f(g0[1]) * u0[1]);
                w.y = cvt_pk_bf16(silu_f(g0[2]) * u0[2], silu_f(g0[3]) * u0[3]);
                w.z = cvt_pk_bf16(silu_f(g1[0]) * u1[0], silu_f(g1[1]) * u1[1]);
                w.w = cvt_pk_bf16(silu_f(g1[2]) * u1[2], silu_f(g1[3]) * u1[3]);
                *(u32x4*)p = w;
            }
    }
};
struct EpiResid {
    static constexpr bool PERM = false, AFTER_DRAIN = false;
    float* X; const float* gate; float gs;
    __device__ __forceinline__ void operator()(const f32x4 (&acc)[2][2][4][2], const Unit& u, int wr, int wc, int fr, int fq) const {
        const int midx = (u.pm % 9 == 8) ? 8 : (u.pm / 9);
        const float* gp = gate + midx * 9216;
        const int row0 = u.pm * BM + wr * 64 + fr, col0 = u.pn * BM + wc * 32 + 4 * fq;
#pragma unroll
        for (int bj = 0; bj < 2; ++bj)
#pragma unroll
            for (int n = 0; n < 2; ++n) {
                const f32x4 gv = *(const f32x4*)(gp + col0 + bj * HALF + n * 16) * gs;
#pragma unroll
                for (int ai = 0; ai < 2; ++ai)
#pragma unroll
                    for (int m = 0; m < 4; ++m) {
                        float* p = X + (size_t)(row0 + ai * HALF + m * 16) * 1024 + col0 + bj * HALF + n * 16;
                        f32x4 x = *(const f32x4*)p; x += gv * acc[ai][bj][m][n]; *(f32x4*)p = x;
                    }
                asm volatile("" ::: "memory");
            }
    }
};
struct EpiStore {
    static constexpr bool PERM = true, AFTER_DRAIN = false;
    bf16_t* O; int ldc;
    __device__ __forceinline__ void operator()(const f32x4 (&acc)[2][2][4][2], const Unit& u, int wr, int wc, int fr, int fq) const {
        const int row0 = u.pm * BM + wr * 64 + fr, col0 = u.pn * BM + wc * 32 + 8 * fq;
#pragma unroll
        for (int ai = 0; ai < 2; ++ai)
#pragma unroll
            for (int m = 0; m < 4; ++m) {
                bf16_t* p = O + (size_t)(row0 + ai * HALF + m * 16) * ldc + col0;
#pragma unroll
                for (int bj = 0; bj < 2; ++bj) {
                    const f32x4 v0 = acc[ai][bj][m][0], v1 = acc[ai][bj][m][1];
                    u32x4 w; w.x = cvt_pk_bf16(v0[0], v0[1]); w.y = cvt_pk_bf16(v0[2], v0[3]); w.z = cvt_pk_bf16(v1[0], v1[1]); w.w = cvt_pk_bf16(v1[2], v1[3]);
                    *(u32x4*)(p + bj * HALF) = w;
                }
            }
    }
};
}

#define LAS __attribute__((address_space(3)))
typedef unsigned short bf16_t;
typedef short bf16x8 __attribute__((ext_vector_type(8)));
typedef short s16x4 __attribute__((ext_vector_type(4)));
typedef float f32x4 __attribute__((ext_vector_type(4)));
typedef float f32x16 __attribute__((ext_vector_type(16)));
typedef unsigned u32x4 __attribute__((ext_vector_type(4)));
typedef unsigned u32x2 __attribute__((ext_vector_type(2)));

constexpr int D = 1024, NB = 8, SEQ = 2048, CTX = 256, TPB = SEQ + CTX  , T = NB * TPB  ;
constexpr int DFF = 2816, NMOD = 9, MODW = NMOD * D  ;
constexpr float EPS = 1e-6f, LOG2E = 1.4426950408889634f;
constexpr int LDS_BYTES = 147456;

constexpr size_t al(size_t x) { return (x + 255) & ~(size_t)255; }
constexpr size_t WS_MOD = 0;
constexpr size_t WS_X = al(WS_MOD + (size_t)4 * 9 * MODW * 4);
constexpr size_t WS_H = al(WS_X + (size_t)T * D * 4);
constexpr size_t WS_ACT = al(WS_H + (size_t)T * D * 2);
constexpr size_t WS_QKV = al(WS_ACT + (size_t)T * DFF * 2);
constexpr size_t WS_O = al(WS_QKV + (size_t)T * 3072 * 2);
constexpr size_t WS_WIN = al(WS_O + (size_t)T * D * 2);
constexpr size_t WS_WOUT = al(WS_WIN + (size_t)8 * 5632 * 1024 * 2);
constexpr size_t WS_WA_QKV = al(WS_WOUT + (size_t)8 * 1024 * 2816 * 2);
constexpr size_t WS_WA_O = al(WS_WA_QKV + (size_t)3072 * 1024 * 2);
constexpr size_t WS_WB_QKV = al(WS_WA_O + (size_t)1024 * 1024 * 2);
constexpr size_t WS_WB_O = al(WS_WB_QKV + (size_t)1536 * 1024 * 2);
constexpr size_t WS_WC_DOWN = al(WS_WB_O + (size_t)1024 * 1024 * 2);
constexpr size_t WS_WC_UQ = al(WS_WC_DOWN + (size_t)512 * 1024 * 2);
constexpr size_t WS_WC_UKV = al(WS_WC_UQ + (size_t)1536 * 256 * 2);
constexpr size_t WS_WC_O = al(WS_WC_UKV + (size_t)2048 * 128 * 2);
constexpr size_t WS_WD_QKV = al(WS_WC_O + (size_t)1024 * 1024 * 2);
constexpr size_t WS_WD_O = al(WS_WD_QKV + (size_t)3072 * 1024 * 2);
constexpr size_t WS_END = al(WS_WD_O + (size_t)1024 * 1024 * 2);
constexpr size_t WS_QM = WS_QKV;
constexpr size_t WS_DOWN = al(WS_QM + (size_t)T * 1536 * 2);
constexpr size_t WS_CQN = al(WS_DOWN + (size_t)T * 512 * 2);
constexpr size_t WS_CKVN = al(WS_CQN + (size_t)T * 256 * 2);
constexpr size_t WS_KPE = al(WS_CKVN + (size_t)T * 128 * 2);
static_assert(WS_KPE + (size_t)T * 32 * 2 <= WS_O, "MLA buffers fit in the QKV region");
constexpr size_t WS_KVM = WS_ACT;
static_assert((size_t)T * 2048 * 2 <= (size_t)T * DFF * 2, "KVM fits in ACT");

struct Args { const float* in[30]; float* out; unsigned char* ws; };

__device__ __forceinline__ float wave_sum(float v) {
#pragma unroll
    for (int o = 1; o < 64; o <<= 1) v += __shfl_xor(v, o);
    return v;
}
__device__ __forceinline__ unsigned f2bf(float f) { unsigned u = __builtin_bit_cast(unsigned, f); return (u + 0x7fffu + ((u >> 16) & 1u)) >> 16; }
typedef float f32x2_t __attribute__((ext_vector_type(2))); typedef __bf16 bf16x2_t __attribute__((ext_vector_type(2)));
__device__ __forceinline__ unsigned pk2(float lo, float hi) { f32x2_t v = {lo, hi}; bf16x2_t r = __builtin_convertvector(v, bf16x2_t); return __builtin_bit_cast(unsigned, r); }
__device__ __forceinline__ float bf_lo(unsigned w) { return __builtin_bit_cast(float, w << 16); }
__device__ __forceinline__ float bf_hi(unsigned w) { return __builtin_bit_cast(float, w & 0xffff0000u); }
__device__ __forceinline__ void rope_cs(int pos, int j, float log2theta_over_nf, float& c, float& s) {
    const float inv = __builtin_amdgcn_exp2f(-(float)j * log2theta_over_nf);
    const float ang = (float)pos * inv;
    c = __cosf(ang); s = __sinf(ang);
}
constexpr float L2T = 13.287712379549449f;

__device__ __forceinline__ void transpose_item(const float* W, int K, int N, bf16_t* WT, int k0, int n0, int dst_row0, LAS float* scr, int lane) {
#pragma unroll 8
    for (int i = 0; i < 32; ++i) { const int kk = 2 * i + (lane >> 5); scr[kk * 33 + (lane & 31)] = W[(size_t)(k0 + kk) * N + n0 + (lane & 31)]; }
    asm volatile("s_waitcnt lgkmcnt(0)" ::: "memory");
    const int c = lane & 7;
#pragma unroll
    for (int j = 0; j < 4; ++j) { const int n = (lane >> 3) + 8 * j; const LAS float* s = scr + (8 * c) * 33 + n;
        u32x4 o; o.x = pk2(s[0 * 33], s[1 * 33]); o.y = pk2(s[2 * 33], s[3 * 33]); o.z = pk2(s[4 * 33], s[5 * 33]); o.w = pk2(s[6 * 33], s[7 * 33]);
        *(u32x4*)(WT + (size_t)(dst_row0 + n) * K + k0 + 8 * c) = o; }
    asm volatile("s_waitcnt lgkmcnt(0)" ::: "memory");
}
__device__ __forceinline__ void conv_item_plain(const float* W, int K, int N, bf16_t* WT, int item, LAS float* scr, int lane) {
    const int nblk = N / 32, kb = item / nblk, nb = item % nblk;
    transpose_item(W, K, N, WT, 64 * kb, 32 * nb, 32 * nb, scr, lane);
}

__device__ __forceinline__ void norm_phase(const float* X, const float* g, const float* modl, int shift_idx, int scale_idx, bf16_t* H, int gw, int ngw, int lane) {
    for (int row = gw; row < T; row += ngw) {
        const int b = row / TPB, t = row - b * TPB, midx = (t >= SEQ) ? 8 : b;
        const float* mp = modl + midx * MODW;
        const f32x4* xr = (const f32x4*)(X + (size_t)row * D) + lane;
        f32x4 v[4]; float ss = 0.f;
#pragma unroll
        for (int j = 0; j < 4; ++j) { v[j] = xr[64 * j]; ss += (v[j].x * v[j].x + v[j].y * v[j].y) + (v[j].z * v[j].z + v[j].w * v[j].w); }
        const float r = 1.0f / sqrtf(wave_sum(ss) * (1.0f / D) + EPS);
        u32x2* o8 = (u32x2*)(H + (size_t)row * D) + lane;
#pragma unroll
        for (int j = 0; j < 4; ++j) {
            const int col = 4 * (lane + 64 * j);
            const f32x4 gg = *(const f32x4*)(g + col), sc = *(const f32x4*)(mp + scale_idx * D + col), sh = *(const f32x4*)(mp + shift_idx * D + col);
            const f32x4 y = (v[j] * r * gg) * (sc + 1.0f) + sh;
            u32x2 w; w.x = pk2(y.x, y.y); w.y = pk2(y.z, y.w); o8[64 * j] = w;
        }
    }
}

template <int MODE> struct ACfg;
template <> struct ACfg<0> { static constexpr int KW = 128, DQK = 64, DV = 128; };
template <> struct ACfg<1> { static constexpr int KW = 64, DQK = 64, DV = 64; };
template <> struct ACfg<2> { static constexpr int KW = 96, DQK = 96, DV = 64; };
template <> struct ACfg<3> { static constexpr int KW = 64, DQK = 64, DV = 64; };
struct AttnP { const bf16_t* q; const bf16_t* k; const bf16_t* k2; const bf16_t* v; bf16_t* o; int ldq, ldk, ldv; const float* rpb; float lam; const float* subln; float c; };
__device__ __forceinline__ int crow(int r, int hi) { return (r & 3) + 8 * (r >> 2) + 4 * hi; }
#define MFMA32(a, b, c) __builtin_amdgcn_mfma_f32_32x32x16_bf16((a), (b), (c), 0, 0, 0)

template <int MODE>
__device__ __forceinline__ void attn_phase(LAS unsigned char* lds, const AttnP P, int vcu, int G) {
    using C = ACfg<MODE>;
    constexpr int KW = C::KW, DQK = C::DQK, DV = C::DV;
    constexpr int RSK = (KW + 8) * 2, RSV = 136, KBUF = 64 * RSK, VBUF = DV * RSV;
    constexpr int OFFV = 2 * KBUF, OFFR = 2 * KBUF + 2 * VBUF;
    constexpr int NQS = DQK / 16, NDB = DV / 32;
    constexpr int KPR = KW / 8, NCK = 64 * KPR, KCH = (NCK + 511) / 512;
    constexpr int VPR = DV / 8, NCV = 32 * VPR;
    static_assert(OFFR + 465 * 4 <= 131072, "attention LDS");
    int tid_l = threadIdx.x; asm volatile("" : "+v"(tid_l));
    const int tid = tid_l, lane = tid & 63, l31 = lane & 31, hi = lane >> 5;
    const int wid = __builtin_amdgcn_readfirstlane(tid >> 6);
    constexpr int NLAT = 1024, NCTX = (MODE == 3) ? 0 : 128;
    LAS float* rpbL = (LAS float*)(lds + OFFR);
    for (int u = vcu; u < NLAT + NCTX; u += G) {
        int b, hh, qbase, t0, n0, t1 = 0, n1 = 0;
        if (u < NLAT) {
            if (MODE == 0) { qbase = (u & 15) * 128; hh = (u >> 4) & 7; }
            else if (MODE == 1) { qbase = (u & 31) * 64; hh = (u >> 5) & 3; }
            else { qbase = (u & 7) * 256; hh = (u >> 3) & 15; }
            b = u >> 7; t0 = 0; n0 = 36;
            if (MODE == 3) { t0 = 32; n0 = 4; const int r0 = (u & 7) * 4; const int jlo = min(max(r0 - 4, 0), 24), jhi = min(max(r0 - 1, 0), 24) + 7; t1 = jlo; n1 = jhi - jlo + 1; }
        } else {
            const int uu = u - NLAT; b = uu >> 4; t0 = 32; n0 = 4;
            if (MODE == 0) { qbase = SEQ + (uu & 1) * 128; hh = (uu >> 1) & 7; }
            else if (MODE == 1) { qbase = SEQ + (uu & 3) * 64; hh = (uu >> 2) & 3; }
            else { qbase = SEQ; hh = uu & 15; }
        }
        int qloc, qcol, kcol, vcol, ocol, koff = 0;
        if (MODE == 0) { const int m = wid >> 2; qloc = (wid & 3) * 32 + l31; qcol = hh * 128 + m * 64; kcol = 1024 + hh * 128; vcol = 2048 + hh * 128; ocol = hh * 128; koff = m * 64; }
        else if (MODE == 1) { const int g = wid >> 1; qloc = (wid & 1) * 32 + l31; qcol = (hh * 4 + g) * 64; kcol = 1024 + hh * 64; vcol = 1280 + hh * 64; ocol = qcol; }
        else if (MODE == 2) { qloc = wid * 32 + l31; qcol = hh * 96; kcol = hh * 128; vcol = hh * 128 + 64; ocol = hh * 64; }
        else { qloc = wid * 32 + l31; qcol = hh * 64; kcol = 1024 + hh * 64; vcol = 2048 + hh * 64; ocol = hh * 64; }
        const size_t rb = (size_t)b * TPB;
        const size_t qrow = rb + qbase + qloc;
        bf16x8 qf[NQS];
#pragma unroll
        for (int st = 0; st < NQS; ++st) qf[st] = *(const bf16x8*)(P.q + qrow * P.ldq + qcol + st * 16 + hi * 8);
        const int gr = (qbase >> 6) + (wid >> 1), qc = (wid & 1) * 32 + l31;
        const int rs = min(max(gr - 4, 0), 24), cs = min(max(qc - 8, 0), 48);
        if (MODE == 3) { for (int i = tid; i < 465; i += 512) rpbL[i] = P.rpb[hh * 465 + i] * LOG2E; }

        u32x4 kreg[KCH], vreg[2];
#define ATT_LOAD(tile) do { const size_t krow0 = rb + (size_t)(tile) * 64; \
        _Pragma("unroll") for (int i = 0; i < KCH; ++i) { const int c_ = tid + 512 * i; if (c_ < NCK) { const int key = c_ / KPR, part = c_ % KPR; \
            const bf16_t* src = (MODE == 2 && part >= 8) ? (P.k2 + (krow0 + key) * 32 + (part - 8) * 8) : (P.k + (krow0 + key) * P.ldk + kcol + part * 8); \
            kreg[i] = *(const u32x4*)src; } } \
        if (tid < NCV) { const int pr = tid / VPR, dp = tid % VPR; const bf16_t* src = P.v + (krow0 + 2 * pr) * P.ldv + vcol + dp * 8; \
            vreg[0] = *(const u32x4*)src; vreg[1] = *(const u32x4*)(src + P.ldv); } } while (0)
#define ATT_WRITE(buf) do { \
        _Pragma("unroll") for (int i = 0; i < KCH; ++i) { const int c_ = tid + 512 * i; if (c_ < NCK) { const int key = c_ / KPR, part = c_ % KPR; \
            *(LAS u32x4*)(lds + (buf) * KBUF + key * RSK + part * 16) = kreg[i]; } } \
        if (tid < NCV) { const int pr = tid / VPR, dp = tid % VPR; LAS unsigned char* vb = lds + OFFV + (buf) * VBUF + (dp * 8) * RSV + pr * 4; \
            _Pragma("unroll") for (int e = 0; e < 4; ++e) { const unsigned a = vreg[0][e], bq = vreg[1][e]; \
                *(LAS unsigned*)(vb + (2 * e) * RSV) = (a & 0xffffu) | (bq << 16); \
                *(LAS unsigned*)(vb + (2 * e + 1) * RSV) = (a >> 16) | (bq & 0xffff0000u); } } } while (0)

        ATT_LOAD(t0);
        ATT_WRITE(0);
        __syncthreads();
        float m_run = -1e30f, l_run = 0.f;
        f32x16 o[NDB];
#pragma unroll
        for (int d = 0; d < NDB; ++d)
#pragma unroll
            for (int r = 0; r < 16; ++r) o[d][r] = 0.f;
        const int nt = n0 + n1;
        for (int it = 0; it < nt; ++it) {
            const int cur = it & 1;
            if (it + 1 < nt) { const int tn = (it + 1 < n0) ? (t0 + it + 1) : (t1 + (it + 1 - n0)); ATT_LOAD(tn); }
            bool active = true; int jrow = 0;
            const bool nbt = (MODE == 3) && (it >= n0);
            if (nbt) { jrow = t1 + it - n0; active = (jrow >= rs) && (jrow < rs + 8); }
            if (active) {
                const LAS unsigned char* kb_ = lds + cur * KBUF;
                const LAS unsigned char* vb_ = lds + OFFV + cur * VBUF;
                f32x16 s[2];
#pragma unroll
                for (int kb = 0; kb < 2; ++kb) {
#pragma unroll
                    for (int r = 0; r < 16; ++r) s[kb][r] = 0.f;
#pragma unroll
                    for (int st = 0; st < NQS; ++st) {
                        const bf16x8 kf = *(const LAS bf16x8*)(kb_ + (kb * 32 + l31) * RSK + (koff + st * 16 + hi * 8) * 2);
                        s[kb] = MFMA32(kf, qf[st], s[kb]);
                    }
                    if (NDB > 2) __builtin_amdgcn_sched_barrier(0);
                }
                float mx = -1e30f;
                if (nbt) {
                    const int ridx = (jrow - gr + 7) * 31;
#pragma unroll
                    for (int kb = 0; kb < 2; ++kb)
#pragma unroll
                        for (int r = 0; r < 16; ++r) {
                            const int cc = kb * 32 + crow(r, hi);
                            const int cidx = min(max(cc - qc + 15, 0), 30);
                            const bool valid = (cc >= cs) && (cc < cs + 16);
                            const float tv = valid ? (s[kb][r] * P.c + rpbL[ridx + cidx]) : -1e30f;
                            s[kb][r] = tv; mx = fmaxf(mx, tv);
                        }
                } else {
#pragma unroll
                    for (int kb = 0; kb < 2; ++kb)
#pragma unroll
                        for (int r = 0; r < 16; ++r) mx = fmaxf(mx, s[kb][r]);
                    mx *= P.c;
                }
                mx = fmaxf(mx, __shfl_xor(mx, 32));
                const float m_new = fmaxf(m_run, mx);
                const float alpha = __builtin_amdgcn_exp2f(m_run - m_new);
                m_run = m_new;
                float ps = 0.f;
                if (nbt) {
#pragma unroll
                    for (int kb = 0; kb < 2; ++kb)
#pragma unroll
                        for (int r = 0; r < 16; ++r) { const float pv = __builtin_amdgcn_exp2f(s[kb][r] - m_new); s[kb][r] = pv; ps += pv; }
                } else {
#pragma unroll
                    for (int kb = 0; kb < 2; ++kb)
#pragma unroll
                        for (int r = 0; r < 16; ++r) { const float pv = __builtin_amdgcn_exp2f(__builtin_fmaf(s[kb][r], P.c, -m_new)); s[kb][r] = pv; ps += pv; }
                }
                l_run = l_run * alpha + ps;
#pragma unroll
                for (int d = 0; d < NDB; ++d)
#pragma unroll
                    for (int r = 0; r < 16; ++r) o[d][r] *= alpha;
                bf16x8 pf[2][2];
#pragma unroll
                for (int kb = 0; kb < 2; ++kb)
#pragma unroll
                    for (int sl = 0; sl < 2; ++sl) {
                        u32x4 w;
                        w.x = pk2(s[kb][8 * sl + 0], s[kb][8 * sl + 1]); w.y = pk2(s[kb][8 * sl + 2], s[kb][8 * sl + 3]);
                        w.z = pk2(s[kb][8 * sl + 4], s[kb][8 * sl + 5]); w.w = pk2(s[kb][8 * sl + 6], s[kb][8 * sl + 7]);
                        pf[kb][sl] = __builtin_bit_cast(bf16x8, w);
                    }
#pragma unroll
                for (int d = 0; d < NDB; ++d) {
#pragma unroll
                    for (int kb = 0; kb < 2; ++kb)
#pragma unroll
                        for (int sl = 0; sl < 2; ++sl) {
                            const LAS unsigned char* vp = vb_ + (d * 32 + l31) * RSV + (kb * 32 + sl * 16 + hi * 4) * 2;
                            const s16x4 lo = *(const LAS s16x4*)vp, hi4 = *(const LAS s16x4*)(vp + 16);
                            const bf16x8 va = __builtin_shufflevector(lo, hi4, 0, 1, 2, 3, 4, 5, 6, 7);
                            o[d] = MFMA32(va, pf[kb][sl], o[d]);
                        }
                    if (NDB > 2) __builtin_amdgcn_sched_barrier(0);
                }
            }
            if (it + 1 < nt) ATT_WRITE(cur ^ 1);
            __syncthreads();
        }
        const float lt = l_run + __shfl_xor(l_run, 32);
        const float inv = 1.0f / lt;
        int lane_e = threadIdx.x & 63; asm volatile("" : "+v"(lane_e));
        const int hi_e = lane_e >> 5, l31_e = lane_e & 31;
        int qloc_e;
        if (MODE == 0) qloc_e = (wid & 3) * 32 + l31_e; else if (MODE == 1) qloc_e = (wid & 1) * 32 + l31_e; else qloc_e = wid * 32 + l31_e;
        bf16_t* op = P.o + (rb + qbase + qloc_e) * D + ocol;
        if (MODE != 0) {
#pragma unroll
            for (int d = 0; d < NDB; ++d)
#pragma unroll
                for (int g4 = 0; g4 < 4; ++g4) {
                    u32x2 w; w.x = pk2(o[d][4 * g4] * inv, o[d][4 * g4 + 1] * inv); w.y = pk2(o[d][4 * g4 + 2] * inv, o[d][4 * g4 + 3] * inv);
                    *(u32x2*)(op + d * 32 + 8 * g4 + 4 * hi_e) = w;
                }
        } else {
            LAS float* comb = (LAS float*)lds;
            if (wid >= 4) {
#pragma unroll
                for (int d = 0; d < NDB; ++d)
#pragma unroll
                    for (int r = 0; r < 16; ++r) comb[(((wid - 4) * 64 + d * 16 + r) * 64) + lane_e] = o[d][r] * inv;
            }
            __syncthreads();
            if (wid < 4) {
                float ss = 0.f;
#pragma unroll
                for (int d = 0; d < NDB; ++d) {
#pragma unroll
                    for (int r = 0; r < 16; ++r) { const float v = o[d][r] * inv - P.lam * comb[((wid * 64 + d * 16 + r) * 64) + lane_e]; o[d][r] = v; ss += v * v; }
                    __builtin_amdgcn_sched_barrier(0);
                }
                ss += __shfl_xor(ss, 32);
                const float rn = (1.0f / sqrtf(ss * (1.0f / 128.0f) + EPS)) * 0.8f;
#pragma unroll
                for (int d = 0; d < NDB; ++d)
#pragma unroll
                    for (int g4 = 0; g4 < 4; ++g4) {
                        const int dd = d * 32 + 8 * g4 + 4 * hi_e;
                        const f32x4 gg = *(const f32x4*)(P.subln + dd);
                        u32x2 w; w.x = pk2(o[d][4 * g4] * rn * gg.x, o[d][4 * g4 + 1] * rn * gg.y); w.y = pk2(o[d][4 * g4 + 2] * rn * gg.z, o[d][4 * g4 + 3] * rn * gg.w);
                        *(u32x2*)(op + dd) = w;
                        __builtin_amdgcn_sched_barrier(0);
                    }
            }
            __syncthreads();
        }
#undef ATT_LOAD
#undef ATT_WRITE
    }
}

#ifndef MEGA
#define MEGA 1
#endif
#define CAS __attribute__((address_space(4)))
#define GET_ARGS const CAS Args* ap_ = (const CAS Args*)__builtin_amdgcn_kernarg_segment_ptr(); asm volatile("" : "+s"(ap_)); const CAS Args& a = *ap_
struct Ids { int tid, lane, wid, G, bx, vcu, gw, ngw, gt, ngt; };
__device__ __forceinline__ Ids make_ids() {
    Ids I; { int t_ = threadIdx.x; asm volatile("" : "+v"(t_)); I.tid = t_; } I.lane = I.tid & 63; I.wid = __builtin_amdgcn_readfirstlane(I.tid >> 6);
    { int g_ = gridDim.x, b_ = blockIdx.x; asm volatile("" : "+s"(g_), "+s"(b_)); I.G = g_; I.bx = b_; } I.vcu = (I.G % 8 == 0) ? (I.bx % 8) * (I.G / 8) + I.bx / 8 : I.bx;
    I.gw = I.bx * 8 + I.wid; I.ngw = I.G * 8; I.gt = I.bx * 512 + I.tid; I.ngt = I.G * 512; return I;
}

__device__ __forceinline__ void ph_prologue(LAS unsigned char* lds) { GET_ARGS;
    const Ids I = make_ids(); const int tid = I.tid, lane = I.lane, wid = I.wid, G = I.G, bx = I.bx;
    unsigned char* ws = a.ws;
    float* MOD = (float*)(ws + WS_MOD); float* X = (float*)(ws + WS_X);
    bf16_t* WIN = (bf16_t*)(ws + WS_WIN); bf16_t* WOUT = (bf16_t*)(ws + WS_WOUT);
    LAS float* S = (LAS float*)lds;
    LAS float* RED = (LAS float*)(lds + 36864);
    for (int i = tid; i < 9 * D; i += 512) { const int r = i >> 10, k = i & 1023; const float v = (r < 8) ? a.in[1][r * D + k] : a.in[3][k]; S[i] = v / (1.0f + __expf(-v)); }
    __syncthreads();
    for (int item = bx; item < 4 * 72; item += G) {
        const int layer = item / 72, cb = (item % 72) * 128;
        const float* w = a.in[4] + (size_t)layer * D * MODW + cb + 2 * lane;
        float acc[9][2];
#pragma unroll
        for (int r = 0; r < 9; ++r) { acc[r][0] = 0.f; acc[r][1] = 0.f; }
        const int kbeg = wid * 128;
#pragma unroll 4
        for (int k = kbeg; k < kbeg + 128; ++k) {
            const float2 wv = *(const float2*)(w + (size_t)k * MODW);
#pragma unroll
            for (int r = 0; r < 9; ++r) { const float sv = S[r * D + k]; acc[r][0] += sv * wv.x; acc[r][1] += sv * wv.y; }
        }
#pragma unroll
        for (int r = 0; r < 9; ++r) { RED[(wid * 9 + r) * 128 + 2 * lane] = acc[r][0]; RED[(wid * 9 + r) * 128 + 2 * lane + 1] = acc[r][1]; }
        __syncthreads();
        for (int i = tid; i < 9 * 128; i += 512) { const int r = i >> 7, cc = i & 127; float s = a.in[5][layer * MODW + cb + cc];
#pragma unroll
            for (int w8 = 0; w8 < 8; ++w8) s += RED[(w8 * 9 + r) * 128 + cc];
            MOD[(size_t)(layer * 9 + r) * MODW + cb + cc] = s; }
        __syncthreads();
    }
    for (int i = I.gt; i < T * (D / 4); i += I.ngt) {
        const int row = i >> 8, c4 = i & 255; const int b = row / TPB, t = row - b * TPB;
        const f32x4* src = (t < SEQ) ? (const f32x4*)(a.in[0] + ((size_t)(b * SEQ + t)) * D) : (const f32x4*)(a.in[2] + ((size_t)(b * CTX + (t - SEQ))) * D);
        ((f32x4*)(X + (size_t)row * D))[c4] = src[c4];
    }
    LAS float* scr = (LAS float*)(lds + 73728 + wid * 8704);
    constexpr int I_IN = (D / 64) * (2 * DFF / 32)  , I_OUT = (DFF / 64) * (D / 32)  ;
    constexpr int I_QKV3 = 16 * 96, I_O = 16 * 32, I_QKVB = 16 * 48, I_DOWN = 16 * 13, I_UQ = 4 * 48, I_UKV = 2 * 64;
    constexpr int NITEMS = 8 * I_IN + 8 * I_OUT + 2 * I_QKV3 + 4 * I_O + I_QKVB + I_DOWN + I_UQ + I_UKV;
    for (int it = I.gw; it < NITEMS; it += I.ngw) {
        int r = it;
        if (r < 8 * I_IN) { const int q = r / I_IN, item = r % I_IN; const int nblk = 2 * DFF / 32, kb = item / nblk, nb = item % nblk; const int n0 = 32 * nb;
            const int j = (n0 < DFF) ? n0 : n0 - DFF; const int dst = (j / 128) * 256 + (j % 128) + ((n0 < DFF) ? 0 : 128);
            transpose_item(a.in[7] + (size_t)q * D * 2 * DFF, D, 2 * DFF, WIN + (size_t)q * 2 * DFF * D, 64 * kb, n0, dst, scr, lane); continue; }
        r -= 8 * I_IN;
        if (r < 8 * I_OUT) { const int q = r / I_OUT, item = r % I_OUT; conv_item_plain(a.in[8] + (size_t)q * DFF * D, DFF, D, WOUT + (size_t)q * D * DFF, item, scr, lane); continue; }
        r -= 8 * I_OUT;
        if (r < I_QKV3) { conv_item_plain(a.in[9], D, 3072, (bf16_t*)(ws + WS_WA_QKV), r, scr, lane); continue; } r -= I_QKV3;
        if (r < I_O) { conv_item_plain(a.in[15], D, D, (bf16_t*)(ws + WS_WA_O), r, scr, lane); continue; } r -= I_O;
        if (r < I_QKVB) { conv_item_plain(a.in[16], D, 1536, (bf16_t*)(ws + WS_WB_QKV), r, scr, lane); continue; } r -= I_QKVB;
        if (r < I_O) { conv_item_plain(a.in[19], D, D, (bf16_t*)(ws + WS_WB_O), r, scr, lane); continue; } r -= I_O;
        if (r < I_DOWN) { conv_item_plain(a.in[20], D, 416, (bf16_t*)(ws + WS_WC_DOWN), r, scr, lane); continue; } r -= I_DOWN;
        if (r < I_UQ) { conv_item_plain(a.in[23], 256, 1536, (bf16_t*)(ws + WS_WC_UQ), r, scr, lane); continue; } r -= I_UQ;
        if (r < I_UKV) { conv_item_plain(a.in[24], 128, 2048, (bf16_t*)(ws + WS_WC_UKV), r, scr, lane); continue; } r -= I_UKV;
        if (r < I_O) { conv_item_plain(a.in[25], D, D, (bf16_t*)(ws + WS_WC_O), r, scr, lane); continue; } r -= I_O;
        if (r < I_QKV3) { conv_item_plain(a.in[26], D, 3072, (bf16_t*)(ws + WS_WD_QKV), r, scr, lane); continue; } r -= I_QKV3;
        conv_item_plain(a.in[28], D, D, (bf16_t*)(ws + WS_WD_O), r, scr, lane);
    }
    { u32x4* z = (u32x4*)((bf16_t*)(ws + WS_WC_DOWN) + (size_t)416 * D); for (int i = I.gt; i < 96 * D / 8; i += I.ngt) z[i] = (u32x4){0u, 0u, 0u, 0u}; }
}

__device__ __forceinline__ void ph_norm(int layer, int which) { GET_ARGS;
    const Ids I = make_ids();
    const float* modl = (const float*)(a.ws + WS_MOD) + (size_t)layer * 9 * MODW;
    norm_phase((const float*)(a.ws + WS_X), a.in[6] + (layer * 3 + which) * D, modl, which * 3, which * 3 + 1, (bf16_t*)(a.ws + WS_H), I.gw, I.ngw, I.lane);
}
__device__ __forceinline__ void ph_ffn1(LAS unsigned char* lds, int layer, int half) { GET_ARGS;
    pg8::Gemm g{(const bf16_t*)(a.ws + WS_H), (const bf16_t*)(a.ws + WS_WIN) + (size_t)(layer * 2 + half) * 2 * DFF * D, T, 2 * DFF, D};
    const Ids I = make_ids(); pg8::StaticOrder S; S.init(T, 2 * DFF, I.G, I.bx);
    pg8::EpiSwiGLU E{(bf16_t*)(a.ws + WS_ACT), DFF};
    pg8::gemm_phase<pg8::EpiSwiGLU, pg8::StaticOrder, true, true>(lds, g, S, E);
}
__device__ __forceinline__ void ph_resid(LAS unsigned char* lds, int layer, int half, int kind) { GET_ARGS;
    const float* modl = (const float*)(a.ws + WS_MOD) + (size_t)layer * 9 * MODW;
    pg8::Gemm g; const float* gate; float gs;
    if (kind == 0) { g = pg8::Gemm{(const bf16_t*)(a.ws + WS_ACT), (const bf16_t*)(a.ws + WS_WOUT) + (size_t)(layer * 2 + half) * D * DFF, T, D, DFF}; gate = modl + (half * 6 + 2) * D; gs = 0.5f; }
    else { const size_t wo = (layer == 0) ? WS_WA_O : (layer == 1) ? WS_WB_O : (layer == 2) ? WS_WC_O : WS_WD_O;
        g = pg8::Gemm{(const bf16_t*)(a.ws + WS_O), (const bf16_t*)(a.ws + wo), T, D, D}; gate = modl + 5 * D; gs = 1.0f; }
    const Ids I = make_ids(); pg8::StaticOrder S; S.init(T, D, I.G, I.bx);
    pg8::EpiResid E{(float*)(a.ws + WS_X), gate, gs};
    pg8::gemm_phase<pg8::EpiResid, pg8::StaticOrder, true, true>(lds, g, S, E);
}
__device__ __forceinline__ void ph_proj(LAS unsigned char* lds, int layer, int step) { GET_ARGS;
    unsigned char* ws = a.ws; const bf16_t* H = (const bf16_t*)(ws + WS_H); bf16_t* QKV = (bf16_t*)(ws + WS_QKV);
    pg8::Gemm gd[2]; bf16_t* outp[2]; int ldo[2]; int ng = 1;
    if (layer == 0) { gd[0] = pg8::Gemm{H, (const bf16_t*)(ws + WS_WA_QKV), T, 3072, D}; outp[0] = QKV; ldo[0] = 3072; }
    else if (layer == 1) { gd[0] = pg8::Gemm{H, (const bf16_t*)(ws + WS_WB_QKV), T, 1536, D}; outp[0] = QKV; ldo[0] = 1536; }
    else if (layer == 3) { gd[0] = pg8::Gemm{H, (const bf16_t*)(ws + WS_WD_QKV), T, 3072, D}; outp[0] = QKV; ldo[0] = 3072; }
    else if (step == 0) { gd[0] = pg8::Gemm{H, (const bf16_t*)(ws + WS_WC_DOWN), T, 512, D}; outp[0] = (bf16_t*)(ws + WS_DOWN); ldo[0] = 512; }
    else { gd[0] = pg8::Gemm{(const bf16_t*)(ws + WS_CQN), (const bf16_t*)(ws + WS_WC_UQ), T, 1536, 256}; outp[0] = (bf16_t*)(ws + WS_QM); ldo[0] = 1536;
           gd[1] = pg8::Gemm{(const bf16_t*)(ws + WS_CKVN), (const bf16_t*)(ws + WS_WC_UKV), T, 2048, 128}; outp[1] = (bf16_t*)(ws + WS_KVM); ldo[1] = 2048; ng = 2; }
    if (ng == 1) { gd[1] = gd[0]; outp[1] = outp[0]; ldo[1] = ldo[0]; }
    const pg8::Gemm g0 = gd[0], g1 = gd[1]; bf16_t* const o0 = outp[0]; bf16_t* const o1 = outp[1]; const int l0 = ldo[0], l1 = ldo[1];
    for (int gi = 0; gi < ng; ++gi) {
        pg8::Gemm gg; gg.A = gi ? g1.A : g0.A; gg.Bt = gi ? g1.Bt : g0.Bt; gg.M = T; gg.N = gi ? g1.N : g0.N; gg.K = gi ? g1.K : g0.K;
        const Ids I = make_ids(); pg8::StaticOrder S; S.init(T, gg.N, I.G, I.bx);
        pg8::EpiStore E{gi ? o1 : o0, gi ? l1 : l0};
        pg8::gemm_phase<pg8::EpiStore, pg8::StaticOrder, true, true>(lds, gg, S, E);
    }
}
template <int LS> __device__ __forceinline__ void ph_post() { GET_ARGS;
    const Ids I = make_ids(); const int lane = I.lane; unsigned char* ws = a.ws; bf16_t* QKV = (bf16_t*)(ws + WS_QKV);
    if (LS == 0) {
        for (int i = I.gt; i < NB * SEQ * 256; i += I.ngt) {
            const int e = i & 7, vec = (i >> 3) & 31, lrow = i >> 8; const int b = lrow >> 11, t = lrow & 2047;
            const int hf = e >> 2, jq = e & 3, pos = hf ? (t & 63) : (t >> 6);
            bf16_t* p1 = QKV + ((size_t)b * TPB + t) * 3072 + vec * 64 + hf * 32 + 4 * jq;
            const u32x2 w1 = *(const u32x2*)p1, w2 = *(const u32x2*)(p1 + 16);
            const float x1[4] = {bf_lo(w1.x), bf_hi(w1.x), bf_lo(w1.y), bf_hi(w1.y)}, x2[4] = {bf_lo(w2.x), bf_hi(w2.x), bf_lo(w2.y), bf_hi(w2.y)};
            float o1[4], o2[4];
#pragma unroll
            for (int q = 0; q < 4; ++q) { float c, s; rope_cs(pos, 4 * jq + q, L2T / 16.0f, c, s); o1[q] = x1[q] * c - x2[q] * s; o2[q] = x1[q] * s + x2[q] * c; }
            u32x2 r1, r2; r1.x = pk2(o1[0], o1[1]); r1.y = pk2(o1[2], o1[3]); r2.x = pk2(o2[0], o2[1]); r2.y = pk2(o2[2], o2[3]);
            *(u32x2*)p1 = r1; *(u32x2*)(p1 + 16) = r2;
        }
    } else if (LS == 2) {
        for (int i = I.gt; i < T * 20 * 8; i += I.ngt) {
            const int e = i & 7, rest = i >> 3, vec = rest % 20, row = rest / 20; const int b = row / TPB, t = row - b * TPB;
            const int hf = e >> 2, jq = e & 3, pos = hf ? (t & 63) : (t >> 6);
            bf16_t* p1 = QKV + (size_t)row * 1536 + vec * 64 + hf * 32 + 4 * jq;
            const u32x2 w1 = *(const u32x2*)p1, w2 = *(const u32x2*)(p1 + 16);
            float x1[4] = {bf_lo(w1.x), bf_hi(w1.x), bf_lo(w1.y), bf_hi(w1.y)}, x2[4] = {bf_lo(w2.x), bf_hi(w2.x), bf_lo(w2.y), bf_hi(w2.y)};
            float ss = 0.f;
#pragma unroll
            for (int q = 0; q < 4; ++q) ss += x1[q] * x1[q] + x2[q] * x2[q];
            ss += __shfl_xor(ss, 1); ss += __shfl_xor(ss, 2); ss += __shfl_xor(ss, 4);
            const float rn = 1.0f / sqrtf(ss * (1.0f / 64.0f) + EPS);
            const float* gg = ((vec < 16) ? a.in[17] : a.in[18]) + hf * 32 + 4 * jq;
            float o1[4], o2[4];
#pragma unroll
            for (int q = 0; q < 4; ++q) { x1[q] = x1[q] * rn * gg[q]; x2[q] = x2[q] * rn * gg[16 + q]; }
            if (t < SEQ) {
#pragma unroll
                for (int q = 0; q < 4; ++q) { float c, s; rope_cs(pos, 4 * jq + q, L2T / 16.0f, c, s); o1[q] = x1[q] * c - x2[q] * s; o2[q] = x1[q] * s + x2[q] * c; }
            } else {
#pragma unroll
                for (int q = 0; q < 4; ++q) { o1[q] = x1[q]; o2[q] = x2[q]; }
            }
            u32x2 r1, r2; r1.x = pk2(o1[0], o1[1]); r1.y = pk2(o1[2], o1[3]); r2.x = pk2(o2[0], o2[1]); r2.y = pk2(o2[2], o2[3]);
            *(u32x2*)p1 = r1; *(u32x2*)(p1 + 16) = r2;
        }
    } else if (LS == 4) {
        const bf16_t* DOWN = (const bf16_t*)(ws + WS_DOWN);
        bf16_t* CQN = (bf16_t*)(ws + WS_CQN); bf16_t* CKVN = (bf16_t*)(ws + WS_CKVN); bf16_t* KPE = (bf16_t*)(ws + WS_KPE);
        for (int row = I.gw; row < T; row += I.ngw) {
            const int b = row / TPB, t = row - b * TPB;
            const bf16_t* dr = DOWN + (size_t)row * 512;
            const u32x2 wq = *(const u32x2*)(dr + 4 * lane);
            const float q4[4] = {bf_lo(wq.x), bf_hi(wq.x), bf_lo(wq.y), bf_hi(wq.y)};
            const float rq = 1.0f / sqrtf(wave_sum(q4[0] * q4[0] + q4[1] * q4[1] + q4[2] * q4[2] + q4[3] * q4[3]) * (1.0f / 256.0f) + EPS);
            const f32x4 gq = *(const f32x4*)(a.in[21] + 4 * lane);
            u32x2 oq; oq.x = pk2(q4[0] * rq * gq.x, q4[1] * rq * gq.y); oq.y = pk2(q4[2] * rq * gq.z, q4[3] * rq * gq.w);
            *(u32x2*)(CQN + (size_t)row * 256 + 4 * lane) = oq;
            const unsigned wk = *(const unsigned*)(dr + 256 + 2 * lane);
            const float k0 = bf_lo(wk), k1 = bf_hi(wk);
            const float rk = 1.0f / sqrtf(wave_sum(k0 * k0 + k1 * k1) * (1.0f / 128.0f) + EPS);
            *(unsigned*)(CKVN + (size_t)row * 128 + 2 * lane) = pk2(k0 * rk * a.in[22][2 * lane], k1 * rk * a.in[22][2 * lane + 1]);
            if (lane < 4) {
                const int hf = lane >> 1, jq = lane & 1, pos = hf ? (t & 63) : (t >> 6);
                const bf16_t* p1 = dr + 384 + hf * 16 + 4 * jq;
                const u32x2 w1 = *(const u32x2*)p1, w2 = *(const u32x2*)(p1 + 8);
                const float x1[4] = {bf_lo(w1.x), bf_hi(w1.x), bf_lo(w1.y), bf_hi(w1.y)}, x2[4] = {bf_lo(w2.x), bf_hi(w2.x), bf_lo(w2.y), bf_hi(w2.y)};
                float o1[4], o2[4];
#pragma unroll
                for (int q = 0; q < 4; ++q) { float c = 1.f, s = 0.f; if (t < SEQ) rope_cs(pos, 4 * jq + q, L2T / 8.0f, c, s); o1[q] = x1[q] * c - x2[q] * s; o2[q] = x1[q] * s + x2[q] * c; }
                u32x2 r1, r2; r1.x = pk2(o1[0], o1[1]); r1.y = pk2(o1[2], o1[3]); r2.x = pk2(o2[0], o2[1]); r2.y = pk2(o2[2], o2[3]);
                bf16_t* po = KPE + (size_t)row * 32 + hf * 16 + 4 * jq;
                *(u32x2*)po = r1; *(u32x2*)(po + 8) = r2;
            }
        }
    } else if (LS == 5) {
        bf16_t* QM = (bf16_t*)(ws + WS_QM);
        for (int i = I.gt; i < NB * SEQ * 64; i += I.ngt) {
            const int e = i & 3, h = (i >> 2) & 15, lrow = i >> 6; const int b = lrow >> 11, t = lrow & 2047;
            const int hf = e >> 1, jq = e & 1, pos = hf ? (t & 63) : (t >> 6);
            bf16_t* p1 = QM + ((size_t)b * TPB + t) * 1536 + h * 96 + 64 + hf * 16 + 4 * jq;
            const u32x2 w1 = *(const u32x2*)p1, w2 = *(const u32x2*)(p1 + 8);
            const float x1[4] = {bf_lo(w1.x), bf_hi(w1.x), bf_lo(w1.y), bf_hi(w1.y)}, x2[4] = {bf_lo(w2.x), bf_hi(w2.x), bf_lo(w2.y), bf_hi(w2.y)};
            float o1[4], o2[4];
#pragma unroll
            for (int q = 0; q < 4; ++q) { float c, s; rope_cs(pos, 4 * jq + q, L2T / 8.0f, c, s); o1[q] = x1[q] * c - x2[q] * s; o2[q] = x1[q] * s + x2[q] * c; }
            u32x2 r1, r2; r1.x = pk2(o1[0], o1[1]); r1.y = pk2(o1[2], o1[3]); r2.x = pk2(o2[0], o2[1]); r2.y = pk2(o2[2], o2[3]);
            *(u32x2*)p1 = r1; *(u32x2*)(p1 + 8) = r2;
        }
    }
}
template <int L> __device__ __forceinline__ void ph_attn(LAS unsigned char* lds) { GET_ARGS;
    const Ids I = make_ids(); unsigned char* ws = a.ws; const bf16_t* QKV = (const bf16_t*)(ws + WS_QKV); bf16_t* OB = (bf16_t*)(ws + WS_O);
    if (L == 0) {
        float s1 = 0.f, s2 = 0.f;
        for (int i = 0; i < 64; ++i) { s1 += a.in[10][i] * a.in[11][i]; s2 += a.in[12][i] * a.in[13][i]; }
        const float lam = __expf(s1) - __expf(s2) + 0.2f;
        AttnP P{QKV, QKV, nullptr, QKV, OB, 3072, 3072, 3072, nullptr, lam, a.in[14], 0.125f * LOG2E};
        attn_phase<0>(lds, P, I.vcu, I.G);
    } else if (L == 1) {
        AttnP P{QKV, QKV, nullptr, QKV, OB, 1536, 1536, 1536, nullptr, 0.f, nullptr, 0.125f * LOG2E};
        attn_phase<1>(lds, P, I.vcu, I.G);
    } else if (L == 2) {
        AttnP P{(const bf16_t*)(ws + WS_QM), (const bf16_t*)(ws + WS_KVM), (const bf16_t*)(ws + WS_KPE), (const bf16_t*)(ws + WS_KVM), OB, 1536, 2048, 2048, nullptr, 0.f, nullptr, 0.10206207261596575f * LOG2E};
        attn_phase<2>(lds, P, I.vcu, I.G);
    } else {
        AttnP P{QKV, QKV, nullptr, QKV, OB, 3072, 3072, 3072, a.in[27], 0.f, nullptr, 0.125f * LOG2E};
        attn_phase<3>(lds, P, I.vcu, I.G);
    }
}
__device__ __forceinline__ void ph_final() { GET_ARGS;
    const Ids I = make_ids(); const int lane = I.lane; const float* X = (const float*)(a.ws + WS_X);
    for (int lrow = I.gw; lrow < NB * SEQ; lrow += I.ngw) {
        const int b = lrow >> 11, t = lrow & 2047;
        const f32x4* xr = (const f32x4*)(X + ((size_t)b * TPB + t) * D) + lane;
        f32x4 v[4]; float ss = 0.f;
#pragma unroll
        for (int j = 0; j < 4; ++j) { v[j] = xr[64 * j]; ss += (v[j].x * v[j].x + v[j].y * v[j].y) + (v[j].z * v[j].z + v[j].w * v[j].w); }
        const float r = 1.0f / sqrtf(wave_sum(ss) * (1.0f / D) + EPS);
        f32x4* orow = (f32x4*)(a.out + (size_t)lrow * D) + lane;
#pragma unroll
        for (int j = 0; j < 4; ++j) { const f32x4 gg = *(const f32x4*)(a.in[29] + 4 * (lane + 64 * j)); orow[64 * j] = v[j] * r * gg; }
    }
}

#define DYN_LDS extern __shared__ __attribute__((aligned(16))) unsigned char lds_raw[]; LAS unsigned char* lds = (LAS unsigned char*)lds_raw

#if MEGA
__global__ void __launch_bounds__(512, 2) mega_fwd(Args a) {
    DYN_LDS;
    cg::grid_group grid = cg::this_grid();
    ph_prologue(lds);
    grid.sync();
    for (int layer = 0; layer < 4; ++layer) {
        for (int half = 0; half < 2; ++half) {
            ph_norm(layer, half * 2); grid.sync();
            ph_ffn1(lds, layer, half); grid.sync();
            ph_resid(lds, layer, half, 0); grid.sync();
            if (half == 1) break;
            ph_norm(layer, 1); grid.sync();
            ph_proj(lds, layer, 0); grid.sync();
            if (layer == 0) { ph_post<0>(); grid.sync(); ph_attn<0>(lds); }
            else if (layer == 1) { ph_post<2>(); grid.sync(); ph_attn<1>(lds); }
            else if (layer == 2) { ph_post<4>(); grid.sync(); ph_proj(lds, layer, 1); grid.sync(); ph_post<5>(); grid.sync(); ph_attn<2>(lds); }
            else { ph_attn<3>(lds); }
            grid.sync();
            ph_resid(lds, layer, 0, 1); grid.sync();
        }
    }
    ph_final();
}
#else
__global__ void __launch_bounds__(512, 2) k_pro(Args a) { DYN_LDS; ph_prologue(lds); }
__global__ void __launch_bounds__(512, 2) k_norm(Args a, int layer, int which) { ph_norm(layer, which); }
__global__ void __launch_bounds__(512, 2) k_ffn1(Args a, int layer, int half) { DYN_LDS; ph_ffn1(lds, layer, half); }
__global__ void __launch_bounds__(512, 2) k_resid(Args a, int layer, int half, int kind) { DYN_LDS; ph_resid(lds, layer, half, kind); }
__global__ void __launch_bounds__(512, 2) k_proj(Args a, int layer, int step) { DYN_LDS; ph_proj(lds, layer, step); }
template <int LS> __global__ void __launch_bounds__(512, 2) k_post(Args a) { ph_post<LS>(); }
template <int L> __global__ void __launch_bounds__(512, 2) k_attn(Args a) { DYN_LDS; ph_attn<L>(lds); }
__global__ void __launch_bounds__(512, 2) k_final(Args a) { ph_final(); }
#endif

extern "C" void kernel_launch(void* const* d_in, const int* in_sizes, int n_in, void* d_out, int out_size, void* d_ws, size_t ws_size, hipStream_t stream) {
    static int grid = 0;
    if (grid == 0) {
        if (n_in != 30 || ws_size < WS_END) { fprintf(stderr, "kernel_launch: bad inputs n_in %d ws %zu need %zu\n", n_in, ws_size, (size_t)WS_END); grid = -1; return; }
        int dev = 0, cus = 0;
        (void)hipGetDevice(&dev);
        (void)hipDeviceGetAttribute(&cus, hipDeviceAttributeMultiprocessorCount, dev);
#if MEGA
        int per_cu = 0;
        if (hipFuncSetAttribute((const void*)mega_fwd, hipFuncAttributeMaxDynamicSharedMemorySize, LDS_BYTES) != hipSuccess) fprintf(stderr, "kernel_launch: hipFuncSetAttribute failed\n");
        if (hipOccupancyMaxActiveBlocksPerMultiprocessor(&per_cu, (const void*)mega_fwd, 512, LDS_BYTES) != hipSuccess || per_cu < 1) { fprintf(stderr, "kernel_launch: occupancy query gave %d\n", per_cu); per_cu = 1; }
        (void)hipGetLastError();
        grid = cus * per_cu;
#else
        (void)hipFuncSetAttribute((const void*)k_pro, hipFuncAttributeMaxDynamicSharedMemorySize, LDS_BYTES);
        (void)hipFuncSetAttribute((const void*)k_ffn1, hipFuncAttributeMaxDynamicSharedMemorySize, LDS_BYTES);
        (void)hipFuncSetAttribute((const void*)k_resid, hipFuncAttributeMaxDynamicSharedMemorySize, LDS_BYTES);
        (void)hipFuncSetAttribute((const void*)k_proj, hipFuncAttributeMaxDynamicSharedMemorySize, LDS_BYTES);
        (void)hipFuncSetAttribute((const void*)k_attn<0>, hipFuncAttributeMaxDynamicSharedMemorySize, LDS_BYTES);
        (void)hipFuncSetAttribute((const void*)k_attn<1>, hipFuncAttributeMaxDynamicSharedMemorySize, LDS_BYTES);
        (void)hipFuncSetAttribute((const void*)k_attn<2>, hipFuncAttributeMaxDynamicSharedMemorySize, LDS_BYTES);
        (void)hipFuncSetAttribute((const void*)k_attn<3>, hipFuncAttributeMaxDynamicSharedMemorySize, LDS_BYTES);
        (void)hipGetLastError();
        grid = cus;
#endif
        if (grid <= 0) grid = 256;
    }
    if (grid < 0) return;
    Args a{};
    for (int i = 0; i < 30; ++i) a.in[i] = (const float*)d_in[i];
    a.out = (float*)d_out; a.ws = (unsigned char*)d_ws;
#if MEGA
    void* args[] = {&a};
    hipError_t e = hipLaunchCooperativeKernel((const void*)mega_fwd, dim3(grid), dim3(512), args, LDS_BYTES, stream);
    if (e != hipSuccess) fprintf(stderr, "kernel_launch: cooperative launch failed: %s (grid %d)\n", hipGetErrorString(e), grid);
#else
    const dim3 g(grid), b(512);
    hipLaunchKernelGGL(k_pro, g, b, LDS_BYTES, stream, a);
    for (int layer = 0; layer < 4; ++layer) {
        for (int half = 0; half < 2; ++half) {
            hipLaunchKernelGGL(k_norm, g, b, 0, stream, a, layer, half * 2);
            hipLaunchKernelGGL(k_ffn1, g, b, LDS_BYTES, stream, a, layer, half);
            hipLaunchKernelGGL(k_resid, g, b, LDS_BYTES, stream, a, layer, half, 0);
            if (half == 1) break;
            hipLaunchKernelGGL(k_norm, g, b, 0, stream, a, layer, 1);
            hipLaunchKernelGGL(k_proj, g, b, LDS_BYTES, stream, a, layer, 0);
            if (layer == 0) { hipLaunchKernelGGL(k_post<0>, g, b, 0, stream, a); hipLaunchKernelGGL(k_attn<0>, g, b, LDS_BYTES, stream, a); }
            else if (layer == 1) { hipLaunchKernelGGL(k_post<2>, g, b, 0, stream, a); hipLaunchKernelGGL(k_attn<1>, g, b, LDS_BYTES, stream, a); }
            else if (layer == 2) { hipLaunchKernelGGL(k_post<4>, g, b, 0, stream, a); hipLaunchKernelGGL(k_proj, g, b, LDS_BYTES, stream, a, layer, 1);
                                   hipLaunchKernelGGL(k_post<5>, g, b, 0, stream, a); hipLaunchKernelGGL(k_attn<2>, g, b, LDS_BYTES, stream, a); }
            else { hipLaunchKernelGGL(k_attn<3>, g, b, LDS_BYTES, stream, a); }
            hipLaunchKernelGGL(k_resid, g, b, LDS_BYTES, stream, a, layer, 0, 1);
        }
    }
    hipLaunchKernelGGL(k_final, g, b, 0, stream, a);
#endif
}
```

```cpp
#include <hip/hip_runtime.h>
#include <hip/hip_cooperative_groups.h>
#include <cstdio>
#include <cstdint>
namespace cg = cooperative_groups;
namespace pg8 {
#define PG8_LAS __attribute__((address_space(3)))
typedef unsigned short bf16_t;
typedef short bf16x8 __attribute__((ext_vector_type(8)));
typedef float f32x4 __attribute__((ext_vector_type(4)));
typedef unsigned u32x4 __attribute__((ext_vector_type(4)));
constexpr int BM = 256, BK = 64, HALF = 128, HTB = HALF * BK * 2  , STAGE_BYTES = 8 * HTB, NXCD = 8, WGM = 8;

__host__ __device__ __forceinline__ int lds_byte(int r, int c) { const int st = (r >> 4) * 2 + (c >> 5), rr = r & 15, cc = c & 31, ob = rr * 64 + cc * 2; return st * 1024 + (ob ^ (((ob >> 9) & 1) << 5)); }
__host__ __device__ __forceinline__ void stage_rc(int b, int& R, int& C) { const int st = b / 1024, sb = b % 1024, swz = sb ^ (((sb >> 9) & 1) << 5); R = (st >> 1) * 16 + swz / 64; C = (st & 1) * 32 + (swz % 64) / 2; }
__host__ __device__ __forceinline__ int perm32(int rho) { const int n = rho >> 4, i = rho & 15; return 8 * (i >> 2) + 4 * n + (i & 3); }

struct Unit { int pm, pn; };
struct Gemm { const bf16_t* A; const bf16_t* Bt; int M, N, K; };

struct StaticOrder {
    int nM, nN, nwg, G, c;
    __host__ __device__ void init(int M, int N, int G_, int c_) { nM = M / BM; nN = N / BM; nwg = nM * nN; G = G_; c = c_; }
    __host__ __device__ bool next(int i, Unit& u) const {
        const long L = (long)i * G + c; if (L >= nwg) return false;
        int wgid = (int)L; { const int q = nwg / NXCD, r = nwg % NXCD, xcd = wgid % NXCD, off = wgid / NXCD; wgid = (xcd < r ? xcd * (q + 1) : r * (q + 1) + (xcd - r) * q) + off; }
        const int nig = WGM * nN, gid = wgid / nig, fm = gid * WGM, gsz = (nM - fm) < WGM ? (nM - fm) : WGM;
        u.pm = fm + ((wgid % nig) % gsz); u.pn = (wgid % nig) / gsz; return true;
    }
    __device__ __forceinline__ void a_ready(const Unit&) const {}
    __device__ __forceinline__ void done(const Unit&) const {}
};

__device__ __forceinline__ unsigned cvt_pk_bf16(float lo, float hi) { unsigned r; asm volatile("v_cvt_pk_bf16_f32 %0, %1, %2" : "=v"(r) : "v"(lo), "v"(hi)); return r; }
typedef float f32x2 __attribute__((ext_vector_type(2)));
template <class Epi, class Sched, bool ALIGN_EPI = false, bool SP2 = false>
__device__ __forceinline__ void gemm_phase(PG8_LAS unsigned char* lds, const Gemm g, const Sched& S, const Epi& E) {
    int tid_l = threadIdx.x; asm volatile("" : "+v"(tid_l));
    const int tid = tid_l, wid = __builtin_amdgcn_readfirstlane(tid >> 6), lane = tid & 63, wr = wid >> 2, wc = wid & 3, fr = lane & 15, fq = lane >> 4;
    const int K = g.K, nt = K / BK;
    unsigned voffA[2], voffB[2];
#pragma unroll
    for (int i = 0; i < 2; ++i) { int R, C; stage_rc(tid * 16 + i * 8192, R, C); const int Rb = Epi::PERM ? ((R & ~31) + perm32(R & 31)) : R;
        voffA[i] = (unsigned)(R * K + C) * 2u; voffB[i] = (unsigned)(Rb * K + C) * 2u; }
    const size_t kstep = (size_t)(BK * 2);
    const size_t hstep = (size_t)HALF * K * 2;
    const size_t tstep = 2 * hstep;
    const unsigned ldsw = (unsigned)wid * 1024u;
    const int aoff = lds_byte(wr * 64 + fr, fq * 8), boff = lds_byte(wc * 32 + fr, fq * 8);
#define PG8_SA(b, h) (((b) * 2 + (h)) * HTB)
#define PG8_SB(b, h) ((4 + (b) * 2 + (h)) * HTB)
#define PG8_STAGE(bufoff, gbase, voff) do { _Pragma("unroll") for (int _i = 0; _i < 2; ++_i) \
        __builtin_amdgcn_global_load_lds((const unsigned*)((const char*)(gbase) + (voff)[_i]), (PG8_LAS unsigned*)(lds + (bufoff) + ldsw + _i * 8192), 16, 0, 0); } while (0)
#define PG8_LDA(dst, b, h) do { _Pragma("unroll") for (int m = 0; m < 4; ++m) _Pragma("unroll") for (int k = 0; k < 2; ++k) dst[m][k] = *(const PG8_LAS bf16x8*)(lds + PG8_SA(b, h) + aoff + m * 2048 + k * 1024); } while (0)
#define PG8_LDB(dst, b, h) do { _Pragma("unroll") for (int n = 0; n < 2; ++n) _Pragma("unroll") for (int k = 0; k < 2; ++k) dst[n][k] = *(const PG8_LAS bf16x8*)(lds + PG8_SB(b, h) + boff + n * 2048 + k * 1024); } while (0)
#define PG8_MMA(ai, bj, At, Bt) do { __builtin_amdgcn_s_setprio(1); _Pragma("unroll") for (int m = 0; m < 4; ++m) _Pragma("unroll") for (int n = 0; n < 2; ++n) _Pragma("unroll") for (int k = 0; k < 2; ++k) \
        acc[ai][bj][m][n] = __builtin_amdgcn_mfma_f32_16x16x32_bf16(Bt[n][k], At[m][k], acc[ai][bj][m][n], 0, 0, 0); __builtin_amdgcn_s_setprio(0); } while (0)
#define PG8_WAIT_V(n) asm volatile("s_waitcnt vmcnt(" #n ")" ::: "memory")
#define PG8_WAIT_L(n) asm volatile("s_waitcnt lgkmcnt(" #n ")" ::: "memory")
#define PG8_BAR __builtin_amdgcn_s_barrier()
#define PG8_SCHED __builtin_amdgcn_sched_barrier(0)
    Unit cur, nxt; int ui = 0;
    if (!S.next(0, cur)) return;
    f32x4 acc[2][2][4][2];
#pragma unroll
    for (int a = 0; a < 2; ++a)
#pragma unroll
        for (int b = 0; b < 2; ++b)
#pragma unroll
            for (int m = 0; m < 4; ++m)
#pragma unroll
                for (int n = 0; n < 2; ++n) acc[a][b][m][n] = (f32x4){0.f, 0.f, 0.f, 0.f};
    bf16x8 At[4][2], B0[2][2], B1[2][2];
    const char* cA = (const char*)g.A + (size_t)cur.pm * tstep; const char* cB = (const char*)g.Bt + (size_t)cur.pn * tstep;
    S.a_ready(cur);
    if constexpr (SP2) {
        PG8_STAGE(PG8_SB(0, 0), cB, voffB); PG8_STAGE(PG8_SB(0, 1), cB + hstep, voffB); PG8_STAGE(PG8_SA(0, 0), cA, voffA); PG8_STAGE(PG8_SA(0, 1), cA + hstep, voffA);
        if (wr == 1) PG8_BAR;
        PG8_WAIT_V(2); PG8_BAR;
        PG8_STAGE(PG8_SB(1, 0), cB + kstep, voffB); PG8_STAGE(PG8_SA(1, 0), cA + kstep, voffA); PG8_STAGE(PG8_SB(1, 1), cB + hstep + kstep, voffB);
        PG8_WAIT_V(6); PG8_BAR;
    } else {
        PG8_STAGE(PG8_SB(0, 0), cB, voffB); PG8_STAGE(PG8_SA(0, 0), cA, voffA); PG8_STAGE(PG8_SB(0, 1), cB + hstep, voffB); PG8_STAGE(PG8_SA(0, 1), cA + hstep, voffA);
        if (wr == 1) PG8_BAR;
        PG8_WAIT_V(4); PG8_BAR;
        PG8_STAGE(PG8_SB(1, 0), cB + kstep, voffB); PG8_STAGE(PG8_SA(1, 0), cA + kstep, voffA); PG8_STAGE(PG8_SB(1, 1), cB + hstep + kstep, voffB);
        PG8_WAIT_V(6); PG8_BAR;
    }
    for (;;) {
        const bool has_next = S.next(ui + 1, nxt);
        const char* nA = has_next ? (const char*)g.A + (size_t)nxt.pm * tstep : cA; const char* nB = has_next ? (const char*)g.Bt + (size_t)nxt.pn * tstep : cB;
        for (int t = 0; t < nt; t += 2) {
            const bool last = (t == nt - 2);
            const char* a1 = cA + (size_t)(t + 1) * kstep;
            const char* a2 = last ? nA : cA + (size_t)(t + 2) * kstep; const char* b2 = last ? nB : cB + (size_t)(t + 2) * kstep;
            const char* a3 = a2 + kstep; const char* b3 = b2 + kstep;
            if (last && has_next) S.a_ready(nxt);
            if constexpr (SP2) {
            PG8_LDB(B0, 0, 0); PG8_LDB(B1, 0, 1); PG8_SCHED; PG8_LDA(At, 0, 0); PG8_STAGE(PG8_SA(1, 1), a1 + hstep, voffA);
            PG8_WAIT_V(8); PG8_WAIT_L(0); PG8_BAR; PG8_MMA(0, 0, At, B0); PG8_MMA(0, 1, At, B1); PG8_BAR; PG8_SCHED;
            PG8_LDA(At, 0, 1); PG8_STAGE(PG8_SB(0, 0), b2, voffB); PG8_STAGE(PG8_SB(0, 1), b2 + hstep, voffB); PG8_STAGE(PG8_SA(0, 0), a2, voffA);
            PG8_WAIT_V(8); PG8_WAIT_L(0); PG8_BAR; PG8_MMA(1, 0, At, B0); PG8_MMA(1, 1, At, B1); PG8_BAR; PG8_SCHED;
            PG8_LDB(B0, 1, 0); PG8_LDB(B1, 1, 1); PG8_SCHED; PG8_LDA(At, 1, 0); PG8_STAGE(PG8_SA(0, 1), a2 + hstep, voffA);
            PG8_WAIT_V(8); PG8_WAIT_L(0); PG8_BAR; PG8_MMA(0, 0, At, B0); PG8_MMA(0, 1, At, B1); PG8_BAR; PG8_SCHED;
            PG8_LDA(At, 1, 1); PG8_STAGE(PG8_SB(1, 0), b3, voffB); PG8_STAGE(PG8_SB(1, 1), b3 + hstep, voffB); PG8_STAGE(PG8_SA(1, 0), a3, voffA);
            PG8_WAIT_V(8); PG8_WAIT_L(0); PG8_BAR; PG8_MMA(1, 0, At, B0); PG8_MMA(1, 1, At, B1); PG8_BAR; PG8_SCHED;
            } else {
            PG8_LDB(B0, 0, 0); PG8_SCHED; PG8_LDA(At, 0, 0); PG8_STAGE(PG8_SA(1, 1), a1 + hstep, voffA);
            PG8_WAIT_L(8); PG8_BAR; PG8_WAIT_L(0); PG8_MMA(0, 0, At, B0); PG8_BAR; PG8_SCHED;
            PG8_LDB(B1, 0, 1); PG8_STAGE(PG8_SB(0, 0), b2, voffB);
            PG8_BAR; PG8_WAIT_L(0); PG8_MMA(0, 1, At, B1); PG8_BAR;
            PG8_LDA(At, 0, 1); PG8_STAGE(PG8_SA(0, 0), a2, voffA);
            PG8_BAR; PG8_WAIT_L(0); PG8_MMA(1, 0, At, B0); PG8_BAR; PG8_SCHED;
            PG8_STAGE(PG8_SB(0, 1), b2 + hstep, voffB);
            PG8_WAIT_V(6); PG8_BAR; PG8_MMA(1, 1, At, B1); PG8_BAR;
            PG8_LDB(B0, 1, 0); PG8_SCHED; PG8_LDA(At, 1, 0); PG8_STAGE(PG8_SA(0, 1), a2 + hstep, voffA);
            PG8_WAIT_L(8); PG8_BAR; PG8_WAIT_L(0); PG8_MMA(0, 0, At, B0); PG8_BAR; PG8_SCHED;
            PG8_LDB(B1, 1, 1); PG8_STAGE(PG8_SB(1, 0), b3, voffB);
            PG8_BAR; PG8_WAIT_L(0); PG8_MMA(0, 1, At, B1); PG8_BAR;
            PG8_LDA(At, 1, 1); PG8_STAGE(PG8_SA(1, 0), a3, voffA);
            PG8_BAR; PG8_WAIT_L(0); PG8_MMA(1, 0, At, B0); PG8_BAR; PG8_SCHED;
            PG8_STAGE(PG8_SB(1, 1), b3 + hstep, voffB);
            PG8_WAIT_V(6); PG8_BAR; PG8_MMA(1, 1, At, B1); PG8_BAR;
            }
        }
        if constexpr (ALIGN_EPI) { if (wr == 0) PG8_BAR; }
        if constexpr (!Epi::AFTER_DRAIN) { E(acc, cur, wr, wc, fr, fq); S.done(cur); }
        if (!has_next) break;
#pragma unroll
        for (int a = 0; a < 2; ++a)
#pragma unroll
            for (int b = 0; b < 2; ++b)
#pragma unroll
                for (int m = 0; m < 4; ++m)
#pragma unroll
                    for (int n = 0; n < 2; ++n) acc[a][b][m][n] = (f32x4){0.f, 0.f, 0.f, 0.f};
        cur = nxt; cA = nA; cB = nB; ++ui;
        if constexpr (ALIGN_EPI) { if (wr == 1) PG8_BAR; }
    }
    PG8_WAIT_V(0);
    if constexpr (!ALIGN_EPI) { if (wr == 0) PG8_BAR; }
    PG8_BAR;
    if constexpr (Epi::AFTER_DRAIN) { E.fused(acc, cur, wr, wc, fr, fq, lds, wid, lane); S.done(cur); }
#undef PG8_SA
#undef PG8_SB
#undef PG8_STAGE
#undef PG8_LDA
#undef PG8_LDB
#undef PG8_MMA
#undef PG8_WAIT_V
#undef PG8_WAIT_L
#undef PG8_BAR
#undef PG8_SCHED
}
}

namespace pg8 {
typedef unsigned u32x2 __attribute__((ext_vector_type(2)));
__device__ __forceinline__ float silu_f(float g) { return g * __builtin_amdgcn_rcpf(1.0f + __builtin_amdgcn_exp2f(-1.4426950408889634f * g)); }
struct EpiSwiGLU {
    static constexpr bool PERM = true, AFTER_DRAIN = false;
    bf16_t* O; int ldc;
    __device__ __forceinline__ void operator()(const f32x4 (&acc)[2][2][4][2], const Unit& u, int wr, int wc, int fr, int fq) const {
        const int row0 = u.pm * BM + wr * 64 + fr, col0 = u.pn * HALF + wc * 32 + 8 * fq;
#pragma unroll
        for (int ai = 0; ai < 2; ++ai)
#pragma unroll
            for (int m = 0; m < 4; ++m) {
                bf16_t* p = O + (size_t)(row0 + ai * HALF + m * 16) * ldc + col0;
                const f32x4 g0 = acc[ai][0][m][0], g1 = acc[ai][0][m][1], u0 = acc[ai][1][m][0], u1 = acc[ai][1][m][1];
                u32x4 w;
                w.x = cvt_pk_bf16(silu_f(g0[0]) * u0[0], silu_f(g0[1]) * u0[1]);
                w.y = cvt_pk_bf16(silu_f(g0[2]) * u0[2], silu_f(g0[3]) * u0[3]);
                w.z = cvt_pk_bf16(silu_f(g1[0]) * u1[0], silu_f(g1[1]) * u1[1]);
                w.w = cvt_pk_bf16(silu_f(g1[2]) * u1[2], silu_f(g1[3]) * u1[3]);
                *(u32x4*)p = w;
            }
    }
};
struct EpiResid {
    static constexpr bool PERM = false, AFTER_DRAIN = false;
    float* X; const float* gate; float gs;
    __device__ __forceinline__ void operator()(const f32x4 (&acc)[2][2][4][2], const Unit& u, int wr, int wc, int fr, int fq) const {
        const int midx = (u.pm % 9 == 8) ? 8 : (u.pm / 9);
        const float* gp = gate + midx * 9216;
        const int row0 = u.pm * BM + wr * 64 + fr, col0 = u.pn * BM + wc * 32 + 4 * fq;
#pragma unroll
        for (int bj = 0; bj < 2; ++bj)
#pragma unroll
            for (int n = 0; n < 2; ++n) {
                const f32x4 gv = *(const f32x4*)(gp + col0 + bj * HALF + n * 16) * gs;
#pragma unroll
                for (int ai = 0; ai < 2; ++ai)
#pragma unroll
                    for (int m = 0; m < 4; ++m) {
                        float* p = X + (size_t)(row0 + ai * HALF + m * 16) * 1024 + col0 + bj * HALF + n * 16;
                        f32x4 x = *(const f32x4*)p; x += gv * acc[ai][bj][m][n]; *(f32x4*)p = x;
                    }
                asm volatile("" ::: "memory");
            }
    }
};
struct EpiStore {
    static constexpr bool PERM = true, AFTER_DRAIN = false;
    bf16_t* O; int ldc;
    __device__ __forceinline__ void operator()(const f32x4 (&acc)[2][2][4][2], const Unit& u, int wr, int wc, int fr, int fq) const {
        const int row0 = u.pm * BM + wr * 64 + fr, col0 = u.pn * BM + wc * 32 + 8 * fq;
#pragma unroll
        for (int ai = 0; ai < 2; ++ai)
#pragma unroll
            for (int m = 0; m < 4; ++m) {
                bf16_t* p = O + (size_t)(row0 + ai * HALF + m * 16) * ldc + col0;
#pragma unroll
                for (int bj = 0; bj < 2; ++bj) {
                    const f32x4 v0 = acc[ai][bj][m][0], v1 = acc[ai][bj][m][1];
                    u32x4 w; w.x = cvt_pk_bf16(v0[0], v0[1]); w.y = cvt_pk_bf16(v0[2], v0[3]); w.z = cvt_pk_bf16(v1[0], v1[1]); w.w = cvt_pk_bf16(v1[2], v1[3]);
                    *(u32x4*)(p + bj * HALF) = w;
                }
            }
    }
};
}

#define LAS __attribute__((address_space(3)))
typedef unsigned short bf16_t;
typedef short bf16x8 __attribute__((ext_vector_type(8)));
typedef short s16x4 __attribute__((ext_vector_type(4)));
typedef float f32x4 __attribute__((ext_vector_type(4)));
typedef float f32x16 __attribute__((ext_vector_type(16)));
typedef unsigned u32x4 __attribute__((ext_vector_type(4)));
typedef unsigned u32x2 __attribute__((ext_vector_type(2)));

constexpr int D = 1024, NB = 8, SEQ = 2048, CTX = 256, TPB = SEQ + CTX  , T = NB * TPB  ;
constexpr int DFF = 2816, NMOD = 9, MODW = NMOD * D  ;
constexpr float EPS = 1e-6f, LOG2E = 1.4426950408889634f;
constexpr int LDS_BYTES = 147456;

constexpr size_t al(size_t x) { return (x + 255) & ~(size_t)255; }
constexpr size_t WS_CTL = 0;
constexpr size_t WS_MOD = 16384;
constexpr size_t WS_X = al(WS_MOD + (size_t)4 * 9 * MODW * 4);
constexpr size_t WS_H = al(WS_X + (size_t)T * D * 4);
constexpr size_t WS_ACT = al(WS_H + (size_t)T * D * 2);
constexpr size_t WS_QKV = al(WS_ACT + (size_t)T * DFF * 2);
constexpr size_t WS_O = al(WS_QKV + (size_t)T * 3072 * 2);
constexpr size_t WS_WIN = al(WS_O + (size_t)T * D * 2);
constexpr size_t WS_WOUT = al(WS_WIN + (size_t)8 * 5632 * 1024 * 2);
constexpr size_t WS_WA_QKV = al(WS_WOUT + (size_t)8 * 1024 * 2816 * 2);
constexpr size_t WS_WA_O = al(WS_WA_QKV + (size_t)3072 * 1024 * 2);
constexpr size_t WS_WB_QKV = al(WS_WA_O + (size_t)1024 * 1024 * 2);
constexpr size_t WS_WB_O = al(WS_WB_QKV + (size_t)1536 * 1024 * 2);
constexpr size_t WS_WC_DOWN = al(WS_WB_O + (size_t)1024 * 1024 * 2);
constexpr size_t WS_WC_UQ = al(WS_WC_DOWN + (size_t)512 * 1024 * 2);
constexpr size_t WS_WC_UKV = al(WS_WC_UQ + (size_t)1536 * 256 * 2);
constexpr size_t WS_WC_O = al(WS_WC_UKV + (size_t)2048 * 128 * 2);
constexpr size_t WS_WD_QKV = al(WS_WC_O + (size_t)1024 * 1024 * 2);
constexpr size_t WS_WD_O = al(WS_WD_QKV + (size_t)3072 * 1024 * 2);
constexpr size_t WS_END = al(WS_WD_O + (size_t)1024 * 1024 * 2);
constexpr size_t WS_QM = WS_QKV;
constexpr size_t WS_DOWN = al(WS_QM + (size_t)T * 1536 * 2);
constexpr size_t WS_CQN = al(WS_DOWN + (size_t)T * 512 * 2);
constexpr size_t WS_CKVN = al(WS_CQN + (size_t)T * 256 * 2);
constexpr size_t WS_KPE = al(WS_CKVN + (size_t)T * 128 * 2);
static_assert(WS_KPE + (size_t)T * 32 * 2 <= WS_O, "MLA buffers fit in the QKV region");
constexpr size_t WS_KVM = WS_ACT;
static_assert((size_t)T * 2048 * 2 <= (size_t)T * DFF * 2, "KVM fits in ACT");

struct Args { const float* in[30]; float* out; unsigned char* ws; };

__device__ __forceinline__ float wave_sum(float v) {
#pragma unroll
    for (int o = 1; o < 64; o <<= 1) v += __shfl_xor(v, o);
    return v;
}
__device__ __forceinline__ unsigned f2bf(float f) { unsigned u = __builtin_bit_cast(unsigned, f); return (u + 0x7fffu + ((u >> 16) & 1u)) >> 16; }
typedef float f32x2_t __attribute__((ext_vector_type(2))); typedef __bf16 bf16x2_t __attribute__((ext_vector_type(2)));
__device__ __forceinline__ unsigned pk2(float lo, float hi) { f32x2_t v = {lo, hi}; bf16x2_t r = __builtin_convertvector(v, bf16x2_t); return __builtin_bit_cast(unsigned, r); }
__device__ __forceinline__ float bf_lo(unsigned w) { return __builtin_bit_cast(float, w << 16); }
__device__ __forceinline__ float bf_hi(unsigned w) { return __builtin_bit_cast(float, w & 0xffff0000u); }
__device__ __forceinline__ void rope_cs(int pos, int j, float log2theta_over_nf, float& c, float& s) {
    const float inv = __builtin_amdgcn_exp2f(-(float)j * log2theta_over_nf);
    const float ang = (float)pos * inv;
    c = __cosf(ang); s = __sinf(ang);
}
constexpr float L2T = 13.287712379549449f;

__device__ __forceinline__ void transpose_item(const float* W, int K, int N, bf16_t* WT, int k0, int n0, int dst_row0, LAS float* scr, int lane) {
#pragma unroll 8
    for (int i = 0; i < 32; ++i) { const int kk = 2 * i + (lane >> 5); scr[kk * 33 + (lane & 31)] = W[(size_t)(k0 + kk) * N + n0 + (lane & 31)]; }
    asm volatile("s_waitcnt lgkmcnt(0)" ::: "memory");
    const int c = lane & 7;
#pragma unroll
    for (int j = 0; j < 4; ++j) { const int n = (lane >> 3) + 8 * j; const LAS float* s = scr + (8 * c) * 33 + n;
        u32x4 o; o.x = pk2(s[0 * 33], s[1 * 33]); o.y = pk2(s[2 * 33], s[3 * 33]); o.z = pk2(s[4 * 33], s[5 * 33]); o.w = pk2(s[6 * 33], s[7 * 33]);
        *(u32x4*)(WT + (size_t)(dst_row0 + n) * K + k0 + 8 * c) = o; }
    asm volatile("s_waitcnt lgkmcnt(0)" ::: "memory");
}
__device__ __forceinline__ void conv_item_plain(const float* W, int K, int N, bf16_t* WT, int item, LAS float* scr, int lane) {
    const int nblk = N / 32, kb = item / nblk, nb = item % nblk;
    transpose_item(W, K, N, WT, 64 * kb, 32 * nb, 32 * nb, scr, lane);
}

__device__ __forceinline__ void norm_phase(const float* X, const float* g, const float* modl, int shift_idx, int scale_idx, bf16_t* H, int gw, int ngw, int lane) {
    for (int row = gw; row < T; row += ngw) {
        const int b = row / TPB, t = row - b * TPB, midx = (t >= SEQ) ? 8 : b;
        const float* mp = modl + midx * MODW;
        const f32x4* xr = (const f32x4*)(X + (size_t)row * D) + lane;
        f32x4 v[4]; float ss = 0.f;
#pragma unroll
        for (int j = 0; j < 4; ++j) { v[j] = xr[64 * j]; ss += (v[j].x * v[j].x + v[j].y * v[j].y) + (v[j].z * v[j].z + v[j].w * v[j].w); }
        const float r = 1.0f / sqrtf(wave_sum(ss) * (1.0f / D) + EPS);
        u32x2* o8 = (u32x2*)(H + (size_t)row * D) + lane;
#pragma unroll
        for (int j = 0; j < 4; ++j) {
            const int col = 4 * (lane + 64 * j);
            const f32x4 gg = *(const f32x4*)(g + col), sc = *(const f32x4*)(mp + scale_idx * D + col), sh = *(const f32x4*)(mp + shift_idx * D + col);
            const f32x4 y = (v[j] * r * gg) * (sc + 1.0f) + sh;
            u32x2 w; w.x = pk2(y.x, y.y); w.y = pk2(y.z, y.w); o8[64 * j] = w;
        }
    }
}

template <int MODE> struct ACfg;
template <> struct ACfg<0> { static constexpr int KW = 128, DQK = 64, DV = 128; };
template <> struct ACfg<1> { static constexpr int KW = 64, DQK = 64, DV = 64; };
template <> struct ACfg<2> { static constexpr int KW = 96, DQK = 96, DV = 64; };
template <> struct ACfg<3> { static constexpr int KW = 64, DQK = 64, DV = 64; };
struct AttnP { const bf16_t* q; const bf16_t* k; const bf16_t* k2; const bf16_t* v; bf16_t* o; int ldq, ldk, ldv; const float* rpb; float lam; const float* subln; float c; };
__device__ __forceinline__ int crow(int r, int hi) { return (r & 3) + 8 * (r >> 2) + 4 * hi; }
#define MFMA32(a, b, c) __builtin_amdgcn_mfma_f32_32x32x16_bf16((a), (b), (c), 0, 0, 0)

template <int MODE>
__device__ __forceinline__ void attn_phase(LAS unsigned char* lds, const AttnP P, int vcu, int G) {
    using C = ACfg<MODE>;
    constexpr int KW = C::KW, DQK = C::DQK, DV = C::DV;
    constexpr int RSK = (KW + 8) * 2, RSV = 136, KBUF = 64 * RSK, VBUF = DV * RSV;
    constexpr int OFFV = 2 * KBUF, OFFR = 2 * KBUF + 2 * VBUF;
    constexpr int NQS = DQK / 16, NDB = DV / 32;
    constexpr int KPR = KW / 8, NCK = 64 * KPR, KCH = (NCK + 511) / 512;
    constexpr int VPR = DV / 8, NCV = 32 * VPR;
    static_assert(OFFR + 465 * 4 <= 131072, "attention LDS");
    int tid_l = threadIdx.x; asm volatile("" : "+v"(tid_l));
    const int tid = tid_l, lane = tid & 63, l31 = lane & 31, hi = lane >> 5;
    const int wid = __builtin_amdgcn_readfirstlane(tid >> 6);
    constexpr int NLAT = 1024, NCTX = (MODE == 3) ? 0 : 128;
    LAS float* rpbL = (LAS float*)(lds + OFFR);
    for (int u = vcu; u < NLAT + NCTX; u += G) {
        int b, hh, qbase, t0, n0, t1 = 0, n1 = 0;
        if (u < NLAT) {
            if (MODE == 0) { qbase = (u & 15) * 128; hh = (u >> 4) & 7; }
            else if (MODE == 1) { qbase = (u & 31) * 64; hh = (u >> 5) & 3; }
            else { qbase = (u & 7) * 256; hh = (u >> 3) & 15; }
            b = u >> 7; t0 = 0; n0 = 36;
            if (MODE == 3) { t0 = 32; n0 = 4; const int r0 = (u & 7) * 4; const int jlo = min(max(r0 - 4, 0), 24), jhi = min(max(r0 - 1, 0), 24) + 7; t1 = jlo; n1 = jhi - jlo + 1; }
        } else {
            const int uu = u - NLAT; b = uu >> 4; t0 = 32; n0 = 4;
            if (MODE == 0) { qbase = SEQ + (uu & 1) * 128; hh = (uu >> 1) & 7; }
            else if (MODE == 1) { qbase = SEQ + (uu & 3) * 64; hh = (uu >> 2) & 3; }
            else { qbase = SEQ; hh = uu & 15; }
        }
        int qloc, qcol, kcol, vcol, ocol, koff = 0;
        if (MODE == 0) { const int m = wid >> 2; qloc = (wid & 3) * 32 + l31; qcol = hh * 128 + m * 64; kcol = 1024 + hh * 128; vcol = 2048 + hh * 128; ocol = hh * 128; koff = m * 64; }
        else if (MODE == 1) { const int g = wid >> 1; qloc = (wid & 1) * 32 + l31; qcol = (hh * 4 + g) * 64; kcol = 1024 + hh * 64; vcol = 1280 + hh * 64; ocol = qcol; }
        else if (MODE == 2) { qloc = wid * 32 + l31; qcol = hh * 96; kcol = hh * 128; vcol = hh * 128 + 64; ocol = hh * 64; }
        else { qloc = wid * 32 + l31; qcol = hh * 64; kcol = 1024 + hh * 64; vcol = 2048 + hh * 64; ocol = hh * 64; }
        const size_t rb = (size_t)b * TPB;
        const size_t qrow = rb + qbase + qloc;
        bf16x8 qf[NQS];
#pragma unroll
        for (int st = 0; st < NQS; ++st) qf[st] = *(const bf16x8*)(P.q + qrow * P.ldq + qcol + st * 16 + hi * 8);
        const int gr = (qbase >> 6) + (wid >> 1), qc = (wid & 1) * 32 + l31;
        const int rs = min(max(gr - 4, 0), 24), cs = min(max(qc - 8, 0), 48);
        if (MODE == 3) { for (int i = tid; i < 465; i += 512) rpbL[i] = P.rpb[hh * 465 + i] * LOG2E; }

        u32x4 kreg[KCH], vreg[2];
#define ATT_LOAD(tile) do { const size_t krow0 = rb + (size_t)(tile) * 64; \
        _Pragma("unroll") for (int i = 0; i < KCH; ++i) { const int c_ = tid + 512 * i; if (c_ < NCK) { const int key = c_ / KPR, part = c_ % KPR; \
            const bf16_t* src = (MODE == 2 && part >= 8) ? (P.k2 + (krow0 + key) * 32 + (part - 8) * 8) : (P.k + (krow0 + key) * P.ldk + kcol + part * 8); \
            kreg[i] = *(const u32x4*)src; } } \
        if (tid < NCV) { const int pr = tid / VPR, dp = tid % VPR; const bf16_t* src = P.v + (krow0 + 2 * pr) * P.ldv + vcol + dp * 8; \
            vreg[0] = *(const u32x4*)src; vreg[1] = *(const u32x4*)(src + P.ldv); } } while (0)
#define ATT_WRITE(buf) do { \
        _Pragma("unroll") for (int i = 0; i < KCH; ++i) { const int c_ = tid + 512 * i; if (c_ < NCK) { const int key = c_ / KPR, part = c_ % KPR; \
            *(LAS u32x4*)(lds + (buf) * KBUF + key * RSK + part * 16) = kreg[i]; } } \
        if (tid < NCV) { const int pr = tid / VPR, dp = tid % VPR; LAS unsigned char* vb = lds + OFFV + (buf) * VBUF + (dp * 8) * RSV + pr * 4; \
            _Pragma("unroll") for (int e = 0; e < 4; ++e) { const unsigned a = vreg[0][e], bq = vreg[1][e]; \
                *(LAS unsigned*)(vb + (2 * e) * RSV) = (a & 0xffffu) | (bq << 16); \
                *(LAS unsigned*)(vb + (2 * e + 1) * RSV) = (a >> 16) | (bq & 0xffff0000u); } } } while (0)

        ATT_LOAD(t0);
        ATT_WRITE(0);
        __syncthreads();
        float m_run = -1e30f, l_run = 0.f;
        f32x16 o[NDB];
#pragma unroll
        for (int d = 0; d < NDB; ++d)
#pragma unroll
            for (int r = 0; r < 16; ++r) o[d][r] = 0.f;
        const int nt = n0 + n1;
        for (int it = 0; it < nt; ++it) {
            const int cur = it & 1;
            if (it + 1 < nt) { const int tn = (it + 1 < n0) ? (t0 + it + 1) : (t1 + (it + 1 - n0)); ATT_LOAD(tn); }
            bool active = true; int jrow = 0;
            const bool nbt = (MODE == 3) && (it >= n0);
            if (nbt) { jrow = t1 + it - n0; active = (jrow >= rs) && (jrow < rs + 8); }
            if (active) {
                const LAS unsigned char* kb_ = lds + cur * KBUF;
                const LAS unsigned char* vb_ = lds + OFFV + cur * VBUF;
                f32x16 s[2];
#pragma unroll
                for (int kb = 0; kb < 2; ++kb) {
#pragma unroll
                    for (int r = 0; r < 16; ++r) s[kb][r] = 0.f;
#pragma unroll
                    for (int st = 0; st < NQS; ++st) {
                        const bf16x8 kf = *(const LAS bf16x8*)(kb_ + (kb * 32 + l31) * RSK + (koff + st * 16 + hi * 8) * 2);
                        s[kb] = MFMA32(kf, qf[st], s[kb]);
                    }
                    if (NDB > 2) __builtin_amdgcn_sched_barrier(0);
                }
                float mx = -1e30f;
                if (nbt) {
                    const int ridx = (jrow - gr + 7) * 31;
#pragma unroll
                    for (int kb = 0; kb < 2; ++kb)
#pragma unroll
                        for (int r = 0; r < 16; ++r) {
                            const int cc = kb * 32 + crow(r, hi);
                            const int cidx = min(max(cc - qc + 15, 0), 30);
                            const bool valid = (cc >= cs) && (cc < cs + 16);
                            const float tv = valid ? (s[kb][r] * P.c + rpbL[ridx + cidx]) : -1e30f;
                            s[kb][r] = tv; mx = fmaxf(mx, tv);
                        }
                } else {
#pragma unroll
                    for (int kb = 0; kb < 2; ++kb)
#pragma unroll
                        for (int r = 0; r < 16; ++r) mx = fmaxf(mx, s[kb][r]);
                    mx *= P.c;
                }
                mx = fmaxf(mx, __shfl_xor(mx, 32));
                const float m_new = fmaxf(m_run, mx);
                const float alpha = __builtin_amdgcn_exp2f(m_run - m_new);
                m_run = m_new;
                float ps = 0.f;
                if (nbt) {
#pragma unroll
                    for (int kb = 0; kb < 2; ++kb)
#pragma unroll
                        for (int r = 0; r < 16; ++r) { const float pv = __builtin_amdgcn_exp2f(s[kb][r] - m_new); s[kb][r] = pv; ps += pv; }
                } else {
#pragma unroll
                    for (int kb = 0; kb < 2; ++kb)
#pragma unroll
                        for (int r = 0; r < 16; ++r) { const float pv = __builtin_amdgcn_exp2f(__builtin_fmaf(s[kb][r], P.c, -m_new)); s[kb][r] = pv; ps += pv; }
                }
                l_run = l_run * alpha + ps;
#pragma unroll
                for (int d = 0; d < NDB; ++d)
#pragma unroll
                    for (int r = 0; r < 16; ++r) o[d][r] *= alpha;
                bf16x8 pf[2][2];
#pragma unroll
                for (int kb = 0; kb < 2; ++kb)
#pragma unroll
                    for (int sl = 0; sl < 2; ++sl) {
                        u32x4 w;
                        w.x = pk2(s[kb][8 * sl + 0], s[kb][8 * sl + 1]); w.y = pk2(s[kb][8 * sl + 2], s[kb][8 * sl + 3]);
                        w.z = pk2(s[kb][8 * sl + 4], s[kb][8 * sl + 5]); w.w = pk2(s[kb][8 * sl + 6], s[kb][8 * sl + 7]);
                        pf[kb][sl] = __builtin_bit_cast(bf16x8, w);
                    }
#pragma unroll
                for (int d = 0; d < NDB; ++d) {
#pragma unroll
                    for (int kb = 0; kb < 2; ++kb)
#pragma unroll
                        for (int sl = 0; sl < 2; ++sl) {
                            const LAS unsigned char* vp = vb_ + (d * 32 + l31) * RSV + (kb * 32 + sl * 16 + hi * 4) * 2;
                            const s16x4 lo = *(const LAS s16x4*)vp, hi4 = *(const LAS s16x4*)(vp + 16);
                            const bf16x8 va = __builtin_shufflevector(lo, hi4, 0, 1, 2, 3, 4, 5, 6, 7);
                            o[d] = MFMA32(va, pf[kb][sl], o[d]);
                        }
                    if (NDB > 2) __builtin_amdgcn_sched_barrier(0);
                }
            }
            if (it + 1 < nt) ATT_WRITE(cur ^ 1);
            __syncthreads();
        }
        const float lt = l_run + __shfl_xor(l_run, 32);
        const float inv = 1.0f / lt;
        int lane_e = threadIdx.x & 63; asm volatile("" : "+v"(lane_e));
        const int hi_e = lane_e >> 5, l31_e = lane_e & 31;
        int qloc_e;
        if (MODE == 0) qloc_e = (wid & 3) * 32 + l31_e; else if (MODE == 1) qloc_e = (wid & 1) * 32 + l31_e; else qloc_e = wid * 32 + l31_e;
        bf16_t* op = P.o + (rb + qbase + qloc_e) * D + ocol;
        if (MODE != 0) {
#pragma unroll
            for (int d = 0; d < NDB; ++d)
#pragma unroll
                for (int g4 = 0; g4 < 4; ++g4) {
                    u32x2 w; w.x = pk2(o[d][4 * g4] * inv, o[d][4 * g4 + 1] * inv); w.y = pk2(o[d][4 * g4 + 2] * inv, o[d][4 * g4 + 3] * inv);
                    *(u32x2*)(op + d * 32 + 8 * g4 + 4 * hi_e) = w;
                }
        } else {
            LAS float* comb = (LAS float*)lds;
            if (wid >= 4) {
#pragma unroll
                for (int d = 0; d < NDB; ++d)
#pragma unroll
                    for (int r = 0; r < 16; ++r) comb[(((wid - 4) * 64 + d * 16 + r) * 64) + lane_e] = o[d][r] * inv;
            }
            __syncthreads();
            if (wid < 4) {
                float ss = 0.f;
#pragma unroll
                for (int d = 0; d < NDB; ++d) {
#pragma unroll
                    for (int r = 0; r < 16; ++r) { const float v = o[d][r] * inv - P.lam * comb[((wid * 64 + d * 16 + r) * 64) + lane_e]; o[d][r] = v; ss += v * v; }
                    __builtin_amdgcn_sched_barrier(0);
                }
                ss += __shfl_xor(ss, 32);
                const float rn = (1.0f / sqrtf(ss * (1.0f / 128.0f) + EPS)) * 0.8f;
#pragma unroll
                for (int d = 0; d < NDB; ++d)
#pragma unroll
                    for (int g4 = 0; g4 < 4; ++g4) {
                        const int dd = d * 32 + 8 * g4 + 4 * hi_e;
                        const f32x4 gg = *(const f32x4*)(P.subln + dd);
                        u32x2 w; w.x = pk2(o[d][4 * g4] * rn * gg.x, o[d][4 * g4 + 1] * rn * gg.y); w.y = pk2(o[d][4 * g4 + 2] * rn * gg.z, o[d][4 * g4 + 3] * rn * gg.w);
                        *(u32x2*)(op + dd) = w;
                        __builtin_amdgcn_sched_barrier(0);
                    }
            }
            __syncthreads();
        }
#undef ATT_LOAD
#undef ATT_WRITE
    }
}

#define XB_TMO      128
#define XB_XCNT(j)  (256  + 64 * (j))
#define XB_XSUB(j)  (1280 + 64 * (j))
#define XB_XGEN(j)  (2304 + 64 * (j))
#define XB_TOP      3328
#define XB_TOPGEN   3392
#define XCD_BAR_WORDS 3456
#define XB_SPIN_CAP (1u << 18)

__device__ __forceinline__ unsigned xb_ld(unsigned* p)              { return __hip_atomic_load(p, __ATOMIC_RELAXED, __HIP_MEMORY_SCOPE_AGENT); }
__device__ __forceinline__ unsigned xb_add(unsigned* p, unsigned v) { return __hip_atomic_fetch_add(p, v, __ATOMIC_RELAXED, __HIP_MEMORY_SCOPE_AGENT); }
__device__ __forceinline__ unsigned xb_xcc_id() { return (unsigned)__builtin_amdgcn_s_getreg((3 << 11) | 20) & 0xFu; }
#define XB_SPIN(cond, bar) do { unsigned _sp = 0; while (cond) { __builtin_amdgcn_s_sleep(1); \
    if ((++_sp & 255u) == 0u) { if (xb_ld(&(bar)[XB_TMO])) break; if (_sp > XB_SPIN_CAP) { atomicAdd(&(bar)[XB_TMO], 1u); break; } } } } while (0)

struct XcdBarrier {
    unsigned* bar; unsigned x;
    volatile LAS unsigned* st;
};

__device__ __forceinline__ XcdBarrier xcd_barrier_post(unsigned* bar, volatile LAS unsigned* st) {
    XcdBarrier b; b.bar = bar; b.x = xb_xcc_id(); b.st = st;
    if (threadIdx.x == 0) (void)xb_add(&bar[XB_XCNT(b.x)], 1u);
    return b;
}
__device__ __forceinline__ void xcd_barrier_complete(unsigned* bar, unsigned x, unsigned& nloc, unsigned& nx) {
    const unsigned G = gridDim.x * gridDim.y * gridDim.z;
    unsigned sum, cnt, mine, sp = 0u;
    for (;;) {
        sum = 0u; cnt = 0u; mine = 0u;
#pragma unroll
        for (unsigned j = 0; j < 16; ++j) { const unsigned c = xb_ld(&bar[XB_XCNT(j)]); sum += c; cnt += (c > 0u) ? 1u : 0u; mine = (j == x) ? c : mine; }
        if (sum == G) break;
        __builtin_amdgcn_s_sleep(1);
        if ((++sp & 255u) == 0u) { if (xb_ld(&bar[XB_TMO])) break; if (sp > XB_SPIN_CAP) { atomicAdd(&bar[XB_TMO], 1u); break; } }
    }
    nloc = mine > 0u ? mine : 1u; nx = cnt > 0u ? cnt : 1u;
}

__device__ __forceinline__ void xcd_barrier(const XcdBarrier& b) {
    asm volatile("s_waitcnt vmcnt(0)" ::: "memory");
    __syncthreads();
    if (threadIdx.x == 0) {
        unsigned* bar = b.bar;
        __builtin_amdgcn_s_waitcnt(0);
        unsigned nloc = b.st[0], nx = b.st[1];
        if (nloc == 0u) { xcd_barrier_complete(bar, b.x, nloc, nx); b.st[0] = nloc; b.st[1] = nx; }
        const unsigned old = xb_add(&bar[XB_XSUB(b.x)], 1u);
        const unsigned gen = old / nloc;
        if (old + 1u == (gen + 1u) * nloc) {
            __builtin_amdgcn_fence(__ATOMIC_RELEASE, "agent");
            asm volatile("s_waitcnt vmcnt(0)" ::: "memory");
            const unsigned og = xb_add(&bar[XB_TOP], 1u);
            const unsigned tg = og / nx;
            if (og + 1u == (tg + 1u) * nx) xb_add(&bar[XB_TOPGEN], 1u);
            else XB_SPIN(xb_ld(&bar[XB_TOPGEN]) == tg, bar);
            __builtin_amdgcn_fence(__ATOMIC_ACQUIRE, "agent");
            xb_add(&bar[XB_XGEN(b.x)], 1u);
            asm volatile("s_waitcnt vmcnt(0)" ::: "memory");
        } else {
            XB_SPIN(xb_ld(&bar[XB_XGEN(b.x)]) == gen, bar);
            __builtin_amdgcn_fence(__ATOMIC_ACQUIRE, "agent");
            asm volatile("s_waitcnt vmcnt(0)" ::: "memory");
        }
    }
    __syncthreads();
}

#ifndef MEGA
#define MEGA 1
#endif
#define CAS __attribute__((address_space(4)))
#define GET_ARGS const CAS Args* ap_ = (const CAS Args*)__builtin_amdgcn_kernarg_segment_ptr(); asm volatile("" : "+s"(ap_)); const CAS Args& a = *ap_
struct Ids { int tid, lane, wid, G, bx, vcu, gw, ngw, gt, ngt; };
__device__ __forceinline__ Ids make_ids() {
    Ids I; { int t_ = threadIdx.x; asm volatile("" : "+v"(t_)); I.tid = t_; } I.lane = I.tid & 63; I.wid = __builtin_amdgcn_readfirstlane(I.tid >> 6);
    { int g_ = gridDim.x, b_ = blockIdx.x; asm volatile("" : "+s"(g_), "+s"(b_)); I.G = g_; I.bx = b_; } I.vcu = (I.G % 8 == 0) ? (I.bx % 8) * (I.G / 8) + I.bx / 8 : I.bx;
    I.gw = I.bx * 8 + I.wid; I.ngw = I.G * 8; I.gt = I.bx * 512 + I.tid; I.ngt = I.G * 512; return I;
}

__device__ __forceinline__ void ph_prologue(LAS unsigned char* lds) { GET_ARGS;
    const Ids I = make_ids(); const int tid = I.tid, lane = I.lane, wid = I.wid, G = I.G, bx = I.bx;
    unsigned char* ws = a.ws;
    float* MOD = (float*)(ws + WS_MOD); float* X = (float*)(ws + WS_X);
    bf16_t* WIN = (bf16_t*)(ws + WS_WIN); bf16_t* WOUT = (bf16_t*)(ws + WS_WOUT);
    LAS float* S = (LAS float*)lds;
    LAS float* RED = (LAS float*)(lds + 36864);
    for (int i = tid; i < 9 * D; i += 512) { const int r = i >> 10, k = i & 1023; const float v = (r < 8) ? a.in[1][r * D + k] : a.in[3][k]; S[i] = v / (1.0f + __expf(-v)); }
    __syncthreads();
    for (int item = bx; item < 4 * 72; item += G) {
        const int layer = item / 72, cb = (item % 72) * 128;
        const float* w = a.in[4] + (size_t)layer * D * MODW + cb + 2 * lane;
        float acc[9][2];
#pragma unroll
        for (int r = 0; r < 9; ++r) { acc[r][0] = 0.f; acc[r][1] = 0.f; }
        const int kbeg = wid * 128;
#pragma unroll 4
        for (int k = kbeg; k < kbeg + 128; ++k) {
            const float2 wv = *(const float2*)(w + (size_t)k * MODW);
#pragma unroll
            for (int r = 0; r < 9; ++r) { const float sv = S[r * D + k]; acc[r][0] += sv * wv.x; acc[r][1] += sv * wv.y; }
        }
#pragma unroll
        for (int r = 0; r < 9; ++r) { RED[(wid * 9 + r) * 128 + 2 * lane] = acc[r][0]; RED[(wid * 9 + r) * 128 + 2 * lane + 1] = acc[r][1]; }
        __syncthreads();
        for (int i = tid; i < 9 * 128; i += 512) { const int r = i >> 7, cc = i & 127; float s = a.in[5][layer * MODW + cb + cc];
#pragma unroll
            for (int w8 = 0; w8 < 8; ++w8) s += RED[(w8 * 9 + r) * 128 + cc];
            MOD[(size_t)(layer * 9 + r) * MODW + cb + cc] = s; }
        __syncthreads();
    }
    for (int i = I.gt; i < T * (D / 4); i += I.ngt) {
        const int row = i >> 8, c4 = i & 255; const int b = row / TPB, t = row - b * TPB;
        const f32x4* src = (t < SEQ) ? (const f32x4*)(a.in[0] + ((size_t)(b * SEQ + t)) * D) : (const f32x4*)(a.in[2] + ((size_t)(b * CTX + (t - SEQ))) * D);
        ((f32x4*)(X + (size_t)row * D))[c4] = src[c4];
    }
    LAS float* scr = (LAS float*)(lds + wid * 8704);
    constexpr int I_IN = (D / 64) * (2 * DFF / 32)  , I_OUT = (DFF / 64) * (D / 32)  ;
    constexpr int I_QKV3 = 16 * 96, I_O = 16 * 32, I_QKVB = 16 * 48, I_DOWN = 16 * 13, I_UQ = 4 * 48, I_UKV = 2 * 64;
    constexpr int NITEMS = 8 * I_IN + 8 * I_OUT + 2 * I_QKV3 + 4 * I_O + I_QKVB + I_DOWN + I_UQ + I_UKV;
    for (int it = I.gw; it < NITEMS; it += I.ngw) {
        int r = it;
        if (r < 8 * I_IN) { const int q = r / I_IN, item = r % I_IN; const int nblk = 2 * DFF / 32, kb = item / nblk, nb = item % nblk; const int n0 = 32 * nb;
            const int j = (n0 < DFF) ? n0 : n0 - DFF; const int dst = (j / 128) * 256 + (j % 128) + ((n0 < DFF) ? 0 : 128);
            transpose_item(a.in[7] + (size_t)q * D * 2 * DFF, D, 2 * DFF, WIN + (size_t)q * 2 * DFF * D, 64 * kb, n0, dst, scr, lane); continue; }
        r -= 8 * I_IN;
        if (r < 8 * I_OUT) { const int q = r / I_OUT, item = r % I_OUT; conv_item_plain(a.in[8] + (size_t)q * DFF * D, DFF, D, WOUT + (size_t)q * D * DFF, item, scr, lane); continue; }
        r -= 8 * I_OUT;
        if (r < I_QKV3) { conv_item_plain(a.in[9], D, 3072, (bf16_t*)(ws + WS_WA_QKV), r, scr, lane); continue; } r -= I_QKV3;
        if (r < I_O) { conv_item_plain(a.in[15], D, D, (bf16_t*)(ws + WS_WA_O), r, scr, lane); continue; } r -= I_O;
        if (r < I_QKVB) { conv_item_plain(a.in[16], D, 1536, (bf16_t*)(ws + WS_WB_QKV), r, scr, lane); continue; } r -= I_QKVB;
        if (r < I_O) { conv_item_plain(a.in[19], D, D, (bf16_t*)(ws + WS_WB_O), r, scr, lane); continue; } r -= I_O;
        if (r < I_DOWN) { conv_item_plain(a.in[20], D, 416, (bf16_t*)(ws + WS_WC_DOWN), r, scr, lane); continue; } r -= I_DOWN;
        if (r < I_UQ) { conv_item_plain(a.in[23], 256, 1536, (bf16_t*)(ws + WS_WC_UQ), r, scr, lane); continue; } r -= I_UQ;
        if (r < I_UKV) { conv_item_plain(a.in[24], 128, 2048, (bf16_t*)(ws + WS_WC_UKV), r, scr, lane); continue; } r -= I_UKV;
        if (r < I_O) { conv_item_plain(a.in[25], D, D, (bf16_t*)(ws + WS_WC_O), r, scr, lane); continue; } r -= I_O;
        if (r < I_QKV3) { conv_item_plain(a.in[26], D, 3072, (bf16_t*)(ws + WS_WD_QKV), r, scr, lane); continue; } r -= I_QKV3;
        conv_item_plain(a.in[28], D, D, (bf16_t*)(ws + WS_WD_O), r, scr, lane);
    }
    { u32x4* z = (u32x4*)((bf16_t*)(ws + WS_WC_DOWN) + (size_t)416 * D); for (int i = I.gt; i < 96 * D / 8; i += I.ngt) z[i] = (u32x4){0u, 0u, 0u, 0u}; }
}

__device__ __forceinline__ void ph_norm(int layer, int which) { GET_ARGS;
    const Ids I = make_ids();
    const float* modl = (const float*)(a.ws + WS_MOD) + (size_t)layer * 9 * MODW;
    norm_phase((const float*)(a.ws + WS_X), a.in[6] + (layer * 3 + which) * D, modl, which * 3, which * 3 + 1, (bf16_t*)(a.ws + WS_H), I.gw, I.ngw, I.lane);
}
__device__ __forceinline__ void ph_ffn1(LAS unsigned char* lds, int layer, int half) { GET_ARGS;
    pg8::Gemm g{(const bf16_t*)(a.ws + WS_H), (const bf16_t*)(a.ws + WS_WIN) + (size_t)(layer * 2 + half) * 2 * DFF * D, T, 2 * DFF, D};
    const Ids I = make_ids(); pg8::StaticOrder S; S.init(T, 2 * DFF, I.G, I.bx);
    pg8::EpiSwiGLU E{(bf16_t*)(a.ws + WS_ACT), DFF};
    pg8::gemm_phase<pg8::EpiSwiGLU, pg8::StaticOrder, true, true>(lds, g, S, E);
}
__device__ __forceinline__ void ph_resid(LAS unsigned char* lds, int layer, int half, int kind) { GET_ARGS;
    const float* modl = (const float*)(a.ws + WS_MOD) + (size_t)layer * 9 * MODW;
    pg8::Gemm g; const float* gate; float gs;
    if (kind == 0) { g = pg8::Gemm{(const bf16_t*)(a.ws + WS_ACT), (const bf16_t*)(a.ws + WS_WOUT) + (size_t)(layer * 2 + half) * D * DFF, T, D, DFF}; gate = modl + (half * 6 + 2) * D; gs = 0.5f; }
    else { const size_t wo = (layer == 0) ? WS_WA_O : (layer == 1) ? WS_WB_O : (layer == 2) ? WS_WC_O : WS_WD_O;
        g = pg8::Gemm{(const bf16_t*)(a.ws + WS_O), (const bf16_t*)(a.ws + wo), T, D, D}; gate = modl + 5 * D; gs = 1.0f; }
    const Ids I = make_ids(); pg8::StaticOrder S; S.init(T, D, I.G, I.bx);
    pg8::EpiResid E{(float*)(a.ws + WS_X), gate, gs};
    pg8::gemm_phase<pg8::EpiResid, pg8::StaticOrder, true, true>(lds, g, S, E);
}
__device__ __forceinline__ void ph_proj(LAS unsigned char* lds, int layer, int step) { GET_ARGS;
    unsigned char* ws = a.ws; const bf16_t* H = (const bf16_t*)(ws + WS_H); bf16_t* QKV = (bf16_t*)(ws + WS_QKV);
    pg8::Gemm gd[2]; bf16_t* outp[2]; int ldo[2]; int ng = 1;
    if (layer == 0) { gd[0] = pg8::Gemm{H, (const bf16_t*)(ws + WS_WA_QKV), T, 3072, D}; outp[0] = QKV; ldo[0] = 3072; }
    else if (layer == 1) { gd[0] = pg8::Gemm{H, (const bf16_t*)(ws + WS_WB_QKV), T, 1536, D}; outp[0] = QKV; ldo[0] = 1536; }
    else if (layer == 3) { gd[0] = pg8::Gemm{H, (const bf16_t*)(ws + WS_WD_QKV), T, 3072, D}; outp[0] = QKV; ldo[0] = 3072; }
    else if (step == 0) { gd[0] = pg8::Gemm{H, (const bf16_t*)(ws + WS_WC_DOWN), T, 512, D}; outp[0] = (bf16_t*)(ws + WS_DOWN); ldo[0] = 512; }
    else { gd[0] = pg8::Gemm{(const bf16_t*)(ws + WS_CQN), (const bf16_t*)(ws + WS_WC_UQ), T, 1536, 256}; outp[0] = (bf16_t*)(ws + WS_QM); ldo[0] = 1536;
           gd[1] = pg8::Gemm{(const bf16_t*)(ws + WS_CKVN), (const bf16_t*)(ws + WS_WC_UKV), T, 2048, 128}; outp[1] = (bf16_t*)(ws + WS_KVM); ldo[1] = 2048; ng = 2; }
    if (ng == 1) { gd[1] = gd[0]; outp[1] = outp[0]; ldo[1] = ldo[0]; }
    const pg8::Gemm g0 = gd[0], g1 = gd[1]; bf16_t* const o0 = outp[0]; bf16_t* const o1 = outp[1]; const int l0 = ldo[0], l1 = ldo[1];
    for (int gi = 0; gi < ng; ++gi) {
        pg8::Gemm gg; gg.A = gi ? g1.A : g0.A; gg.Bt = gi ? g1.Bt : g0.Bt; gg.M = T; gg.N = gi ? g1.N : g0.N; gg.K = gi ? g1.K : g0.K;
        const Ids I = make_ids(); pg8::StaticOrder S; S.init(T, gg.N, I.G, I.bx);
        pg8::EpiStore E{gi ? o1 : o0, gi ? l1 : l0};
        pg8::gemm_phase<pg8::EpiStore, pg8::StaticOrder, true, true>(lds, gg, S, E);
    }
}
template <int LS> __device__ __forceinline__ void ph_post() { GET_ARGS;
    const Ids I = make_ids(); const int lane = I.lane; unsigned char* ws = a.ws; bf16_t* QKV = (bf16_t*)(ws + WS_QKV);
    if (LS == 0) {
        for (int i = I.gt; i < NB * SEQ * 256; i += I.ngt) {
            const int e = i & 7, vec = (i >> 3) & 31, lrow = i >> 8; const int b = lrow >> 11, t = lrow & 2047;
            const int hf = e >> 2, jq = e & 3, pos = hf ? (t & 63) : (t >> 6);
            bf16_t* p1 = QKV + ((size_t)b * TPB + t) * 3072 + vec * 64 + hf * 32 + 4 * jq;
            const u32x2 w1 = *(const u32x2*)p1, w2 = *(const u32x2*)(p1 + 16);
            const float x1[4] = {bf_lo(w1.x), bf_hi(w1.x), bf_lo(w1.y), bf_hi(w1.y)}, x2[4] = {bf_lo(w2.x), bf_hi(w2.x), bf_lo(w2.y), bf_hi(w2.y)};
            float o1[4], o2[4];
#pragma unroll
            for (int q = 0; q < 4; ++q) { float c, s; rope_cs(pos, 4 * jq + q, L2T / 16.0f, c, s); o1[q] = x1[q] * c - x2[q] * s; o2[q] = x1[q] * s + x2[q] * c; }
            u32x2 r1, r2; r1.x = pk2(o1[0], o1[1]); r1.y = pk2(o1[2], o1[3]); r2.x = pk2(o2[0], o2[1]); r2.y = pk2(o2[2], o2[3]);
            *(u32x2*)p1 = r1; *(u32x2*)(p1 + 16) = r2;
        }
    } else if (LS == 2) {
        for (int i = I.gt; i < T * 20 * 8; i += I.ngt) {
            const int e = i & 7, rest = i >> 3, vec = rest % 20, row = rest / 20; const int b = row / TPB, t = row - b * TPB;
            const int hf = e >> 2, jq = e & 3, pos = hf ? (t & 63) : (t >> 6);
            bf16_t* p1 = QKV + (size_t)row * 1536 + vec * 64 + hf * 32 + 4 * jq;
            const u32x2 w1 = *(const u32x2*)p1, w2 = *(const u32x2*)(p1 + 16);
            float x1[4] = {bf_lo(w1.x), bf_hi(w1.x), bf_lo(w1.y), bf_hi(w1.y)}, x2[4] = {bf_lo(w2.x), bf_hi(w2.x), bf_lo(w2.y), bf_hi(w2.y)};
            float ss = 0.f;
#pragma unroll
            for (int q = 0; q < 4; ++q) ss += x1[q] * x1[q] + x2[q] * x2[q];
            ss += __shfl_xor(ss, 1); ss += __shfl_xor(ss, 2); ss += __shfl_xor(ss, 4);
            const float rn = 1.0f / sqrtf(ss * (1.0f / 64.0f) + EPS);
            const float* gg = ((vec < 16) ? a.in[17] : a.in[18]) + hf * 32 + 4 * jq;
            float o1[4], o2[4];
#pragma unroll
            for (int q = 0; q < 4; ++q) { x1[q] = x1[q] * rn * gg[q]; x2[q] = x2[q] * rn * gg[16 + q]; }
            if (t < SEQ) {
#pragma unroll
                for (int q = 0; q < 4; ++q) { float c, s; rope_cs(pos, 4 * jq + q, L2T / 16.0f, c, s); o1[q] = x1[q] * c - x2[q] * s; o2[q] = x1[q] * s + x2[q] * c; }
            } else {
#pragma unroll
                for (int q = 0; q < 4; ++q) { o1[q] = x1[q]; o2[q] = x2[q]; }
            }
            u32x2 r1, r2; r1.x = pk2(o1[0], o1[1]); r1.y = pk2(o1[2], o1[3]); r2.x = pk2(o2[0], o2[1]); r2.y = pk2(o2[2], o2[3]);
            *(u32x2*)p1 = r1; *(u32x2*)(p1 + 16) = r2;
        }
    } else if (LS == 4) {
        const bf16_t* DOWN = (const bf16_t*)(ws + WS_DOWN);
        bf16_t* CQN = (bf16_t*)(ws + WS_CQN); bf16_t* CKVN = (bf16_t*)(ws + WS_CKVN); bf16_t* KPE = (bf16_t*)(ws + WS_KPE);
        for (int row = I.gw; row < T; row += I.ngw) {
            const int b = row / TPB, t = row - b * TPB;
            const bf16_t* dr = DOWN + (size_t)row * 512;
            const u32x2 wq = *(const u32x2*)(dr + 4 * lane);
            const float q4[4] = {bf_lo(wq.x), bf_hi(wq.x), bf_lo(wq.y), bf_hi(wq.y)};
            const float rq = 1.0f / sqrtf(wave_sum(q4[0] * q4[0] + q4[1] * q4[1] + q4[2] * q4[2] + q4[3] * q4[3]) * (1.0f / 256.0f) + EPS);
            const f32x4 gq = *(const f32x4*)(a.in[21] + 4 * lane);
            u32x2 oq; oq.x = pk2(q4[0] * rq * gq.x, q4[1] * rq * gq.y); oq.y = pk2(q4[2] * rq * gq.z, q4[3] * rq * gq.w);
            *(u32x2*)(CQN + (size_t)row * 256 + 4 * lane) = oq;
            const unsigned wk = *(const unsigned*)(dr + 256 + 2 * lane);
            const float k0 = bf_lo(wk), k1 = bf_hi(wk);
            const float rk = 1.0f / sqrtf(wave_sum(k0 * k0 + k1 * k1) * (1.0f / 128.0f) + EPS);
            *(unsigned*)(CKVN + (size_t)row * 128 + 2 * lane) = pk2(k0 * rk * a.in[22][2 * lane], k1 * rk * a.in[22][2 * lane + 1]);
            if (lane < 4) {
                const int hf = lane >> 1, jq = lane & 1, pos = hf ? (t & 63) : (t >> 6);
                const bf16_t* p1 = dr + 384 + hf * 16 + 4 * jq;
                const u32x2 w1 = *(const u32x2*)p1, w2 = *(const u32x2*)(p1 + 8);
                const float x1[4] = {bf_lo(w1.x), bf_hi(w1.x), bf_lo(w1.y), bf_hi(w1.y)}, x2[4] = {bf_lo(w2.x), bf_hi(w2.x), bf_lo(w2.y), bf_hi(w2.y)};
                float o1[4], o2[4];
#pragma unroll
                for (int q = 0; q < 4; ++q) { float c = 1.f, s = 0.f; if (t < SEQ) rope_cs(pos, 4 * jq + q, L2T / 8.0f, c, s); o1[q] = x1[q] * c - x2[q] * s; o2[q] = x1[q] * s + x2[q] * c; }
                u32x2 r1, r2; r1.x = pk2(o1[0], o1[1]); r1.y = pk2(o1[2], o1[3]); r2.x = pk2(o2[0], o2[1]); r2.y = pk2(o2[2], o2[3]);
                bf16_t* po = KPE + (size_t)row * 32 + hf * 16 + 4 * jq;
                *(u32x2*)po = r1; *(u32x2*)(po + 8) = r2;
            }
        }
    } else if (LS == 5) {
        bf16_t* QM = (bf16_t*)(ws + WS_QM);
        for (int i = I.gt; i < NB * SEQ * 64; i += I.ngt) {
            const int e = i & 3, h = (i >> 2) & 15, lrow = i >> 6; const int b = lrow >> 11, t = lrow & 2047;
            const int hf = e >> 1, jq = e & 1, pos = hf ? (t & 63) : (t >> 6);
            bf16_t* p1 = QM + ((size_t)b * TPB + t) * 1536 + h * 96 + 64 + hf * 16 + 4 * jq;
            const u32x2 w1 = *(const u32x2*)p1, w2 = *(const u32x2*)(p1 + 8);
            const float x1[4] = {bf_lo(w1.x), bf_hi(w1.x), bf_lo(w1.y), bf_hi(w1.y)}, x2[4] = {bf_lo(w2.x), bf_hi(w2.x), bf_lo(w2.y), bf_hi(w2.y)};
            float o1[4], o2[4];
#pragma unroll
            for (int q = 0; q < 4; ++q) { float c, s; rope_cs(pos, 4 * jq + q, L2T / 8.0f, c, s); o1[q] = x1[q] * c - x2[q] * s; o2[q] = x1[q] * s + x2[q] * c; }
            u32x2 r1, r2; r1.x = pk2(o1[0], o1[1]); r1.y = pk2(o1[2], o1[3]); r2.x = pk2(o2[0], o2[1]); r2.y = pk2(o2[2], o2[3]);
            *(u32x2*)p1 = r1; *(u32x2*)(p1 + 8) = r2;
        }
    }
}
template <int L> __device__ __forceinline__ void ph_attn(LAS unsigned char* lds) { GET_ARGS;
    const Ids I = make_ids(); unsigned char* ws = a.ws; const bf16_t* QKV = (const bf16_t*)(ws + WS_QKV); bf16_t* OB = (bf16_t*)(ws + WS_O);
    if (L == 0) {
        float s1 = 0.f, s2 = 0.f;
        for (int i = 0; i < 64; ++i) { s1 += a.in[10][i] * a.in[11][i]; s2 += a.in[12][i] * a.in[13][i]; }
        const float lam = __expf(s1) - __expf(s2) + 0.2f;
        AttnP P{QKV, QKV, nullptr, QKV, OB, 3072, 3072, 3072, nullptr, lam, a.in[14], 0.125f * LOG2E};
        attn_phase<0>(lds, P, I.vcu, I.G);
    } else if (L == 1) {
        AttnP P{QKV, QKV, nullptr, QKV, OB, 1536, 1536, 1536, nullptr, 0.f, nullptr, 0.125f * LOG2E};
        attn_phase<1>(lds, P, I.vcu, I.G);
    } else if (L == 2) {
        AttnP P{(const bf16_t*)(ws + WS_QM), (const bf16_t*)(ws + WS_KVM), (const bf16_t*)(ws + WS_KPE), (const bf16_t*)(ws + WS_KVM), OB, 1536, 2048, 2048, nullptr, 0.f, nullptr, 0.10206207261596575f * LOG2E};
        attn_phase<2>(lds, P, I.vcu, I.G);
    } else {
        AttnP P{QKV, QKV, nullptr, QKV, OB, 3072, 3072, 3072, a.in[27], 0.f, nullptr, 0.125f * LOG2E};
        attn_phase<3>(lds, P, I.vcu, I.G);
    }
}
__device__ __forceinline__ void ph_final() { GET_ARGS;
    const Ids I = make_ids(); const int lane = I.lane; const float* X = (const float*)(a.ws + WS_X);
    for (int lrow = I.gw; lrow < NB * SEQ; lrow += I.ngw) {
        const int b = lrow >> 11, t = lrow & 2047;
        const f32x4* xr = (const f32x4*)(X + ((size_t)b * TPB + t) * D) + lane;
        f32x4 v[4]; float ss = 0.f;
#pragma unroll
        for (int j = 0; j < 4; ++j) { v[j] = xr[64 * j]; ss += (v[j].x * v[j].x + v[j].y * v[j].y) + (v[j].z * v[j].z + v[j].w * v[j].w); }
        const float r = 1.0f / sqrtf(wave_sum(ss) * (1.0f / D) + EPS);
        f32x4* orow = (f32x4*)(a.out + (size_t)lrow * D) + lane;
#pragma unroll
        for (int j = 0; j < 4; ++j) { const f32x4 gg = *(const f32x4*)(a.in[29] + 4 * (lane + 64 * j)); orow[64 * j] = v[j] * r * gg; }
    }
}

#define DYN_LDS extern __shared__ __attribute__((aligned(16))) unsigned char lds_raw[]; LAS unsigned char* lds = (LAS unsigned char*)lds_raw

#if MEGA
__global__ void __launch_bounds__(512, 2) mega_fwd(Args a) {
    DYN_LDS;
    cg::grid_group grid = cg::this_grid();
    volatile LAS unsigned* misc = (volatile LAS unsigned*)(lds + 131072 + 320);
    if (threadIdx.x < 32) misc[threadIdx.x] = 0u;
    __syncthreads();
    unsigned* barw; { GET_ARGS; barw = (unsigned*)(a.ws + WS_CTL); }
    const XcdBarrier bar = xcd_barrier_post(barw, misc + 8);
#define GSYNC() xcd_barrier(bar)
    ph_prologue(lds);
    grid.sync();
    for (int layer = 0; layer < 4; ++layer) {
        for (int half = 0; half < 2; ++half) {
            ph_norm(layer, half * 2); GSYNC();
            ph_ffn1(lds, layer, half); GSYNC();
            ph_resid(lds, layer, half, 0); GSYNC();
            if (half == 1) break;
            ph_norm(layer, 1); GSYNC();
            ph_proj(lds, layer, 0); GSYNC();
            if (layer == 0) { ph_post<0>(); GSYNC(); ph_attn<0>(lds); }
            else if (layer == 1) { ph_post<2>(); GSYNC(); ph_attn<1>(lds); }
            else if (layer == 2) { ph_post<4>(); GSYNC(); ph_proj(lds, layer, 1); GSYNC(); ph_post<5>(); GSYNC(); ph_attn<2>(lds); }
            else { ph_attn<3>(lds); }
            GSYNC();
            ph_resid(lds, layer, 0, 1); GSYNC();
        }
    }
    ph_final();
}
#else
__global__ void __launch_bounds__(512, 2) k_pro(Args a) { DYN_LDS; ph_prologue(lds); }
__global__ void __launch_bounds__(512, 2) k_norm(Args a, int layer, int which) { ph_norm(layer, which); }
__global__ void __launch_bounds__(512, 2) k_ffn1(Args a, int layer, int half) { DYN_LDS; ph_ffn1(lds, layer, half); }
__global__ void __launch_bounds__(512, 2) k_resid(Args a, int layer, int half, int kind) { DYN_LDS; ph_resid(lds, layer, half, kind); }
__global__ void __launch_bounds__(512, 2) k_proj(Args a, int layer, int step) { DYN_LDS; ph_proj(lds, layer, step); }
template <int LS> __global__ void __launch_bounds__(512, 2) k_post(Args a) { ph_post<LS>(); }
template <int L> __global__ void __launch_bounds__(512, 2) k_attn(Args a) { DYN_LDS; ph_attn<L>(lds); }
__global__ void __launch_bounds__(512, 2) k_final(Args a) { ph_final(); }
#endif

extern "C" void kernel_launch(void* const* d_in, const int* in_sizes, int n_in, void* d_out, int out_size, void* d_ws, size_t ws_size, hipStream_t stream) {
    static int grid = 0;
    if (grid == 0) {
        if (n_in != 30 || ws_size < WS_END) { fprintf(stderr, "kernel_launch: bad inputs n_in %d ws %zu need %zu\n", n_in, ws_size, (size_t)WS_END); grid = -1; return; }
        int dev = 0, cus = 0;
        (void)hipGetDevice(&dev);
        (void)hipDeviceGetAttribute(&cus, hipDeviceAttributeMultiprocessorCount, dev);
#if MEGA
        int per_cu = 0;
        if (hipFuncSetAttribute((const void*)mega_fwd, hipFuncAttributeMaxDynamicSharedMemorySize, LDS_BYTES) != hipSuccess) fprintf(stderr, "kernel_launch: hipFuncSetAttribute failed\n");
        if (hipOccupancyMaxActiveBlocksPerMultiprocessor(&per_cu, (const void*)mega_fwd, 512, LDS_BYTES) != hipSuccess || per_cu < 1) { fprintf(stderr, "kernel_launch: occupancy query gave %d\n", per_cu); per_cu = 1; }
        (void)hipGetLastError();
        grid = cus * per_cu;
#else
        (void)hipFuncSetAttribute((const void*)k_pro, hipFuncAttributeMaxDynamicSharedMemorySize, LDS_BYTES);
        (void)hipFuncSetAttribute((const void*)k_ffn1, hipFuncAttributeMaxDynamicSharedMemorySize, LDS_BYTES);
        (void)hipFuncSetAttribute((const void*)k_resid, hipFuncAttributeMaxDynamicSharedMemorySize, LDS_BYTES);
        (void)hipFuncSetAttribute((const void*)k_proj, hipFuncAttributeMaxDynamicSharedMemorySize, LDS_BYTES);
        (void)hipFuncSetAttribute((const void*)k_attn<0>, hipFuncAttributeMaxDynamicSharedMemorySize, LDS_BYTES);
        (void)hipFuncSetAttribute((const void*)k_attn<1>, hipFuncAttributeMaxDynamicSharedMemorySize, LDS_BYTES);
        (void)hipFuncSetAttribute((const void*)k_attn<2>, hipFuncAttributeMaxDynamicSharedMemorySize, LDS_BYTES);
        (void)hipFuncSetAttribute((const void*)k_attn<3>, hipFuncAttributeMaxDynamicSharedMemorySize, LDS_BYTES);
        (void)hipGetLastError();
        grid = cus;
#endif
        if (grid <= 0) grid = 256;
    }
    if (grid < 0) return;
    Args a{};
    for (int i = 0; i < 30; ++i) a.in[i] = (const float*)d_in[i];
    a.out = (float*)d_out; a.ws = (unsigned char*)d_ws;
#if MEGA
    (void)hipMemsetAsync((char*)d_ws + WS_CTL, 0, 16384, stream);
    void* args[] = {&a};
    hipError_t e = hipLaunchCooperativeKernel((const void*)mega_fwd, dim3(grid), dim3(512), args, LDS_BYTES, stream);
    if (e != hipSuccess) fprintf(stderr, "kernel_launch: cooperative launch failed: %s (grid %d)\n", hipGetErrorString(e), grid);
#else
    const dim3 g(grid), b(512);
    hipLaunchKernelGGL(k_pro, g, b, LDS_BYTES, stream, a);
    for (int layer = 0; layer < 4; ++layer) {
        for (int half = 0; half < 2; ++half) {
            hipLaunchKernelGGL(k_norm, g, b, 0, stream, a, layer, half * 2);
            hipLaunchKernelGGL(k_ffn1, g, b, LDS_BYTES, stream, a, layer, half);
            hipLaunchKernelGGL(k_resid, g, b, LDS_BYTES, stream, a, layer, half, 0);
            if (half == 1) break;
            hipLaunchKernelGGL(k_norm, g, b, 0, stream, a, layer, 1);
            hipLaunchKernelGGL(k_proj, g, b, LDS_BYTES, stream, a, layer, 0);
            if (layer == 0) { hipLaunchKernelGGL(k_post<0>, g, b, 0, stream, a); hipLaunchKernelGGL(k_attn<0>, g, b, LDS_BYTES, stream, a); }
            else if (layer == 1) { hipLaunchKernelGGL(k_post<2>, g, b, 0, stream, a); hipLaunchKernelGGL(k_attn<1>, g, b, LDS_BYTES, stream, a); }
            else if (layer == 2) { hipLaunchKernelGGL(k_post<4>, g, b, 0, stream, a); hipLaunchKernelGGL(k_proj, g, b, LDS_BYTES, stream, a, layer, 1);
                                   hipLaunchKernelGGL(k_post<5>, g, b, 0, stream, a); hipLaunchKernelGGL(k_attn<2>, g, b, LDS_BYTES, stream, a); }
            else { hipLaunchKernelGGL(k_attn<3>, g, b, LDS_BYTES, stream, a); }
            hipLaunchKernelGGL(k_resid, g, b, LDS_BYTES, stream, a, layer, 0, 1);
        }
    }
    hipLaunchKernelGGL(k_final, g, b, 0, stream, a);
#endif
}
```

```cpp
#include <hip/hip_runtime.h>
#include <hip/hip_cooperative_groups.h>
#include <cstdio>
#include <cstdint>
namespace cg = cooperative_groups;
namespace pg8 {
#define PG8_LAS __attribute__((address_space(3)))
typedef unsigned short bf16_t;
typedef short bf16x8 __attribute__((ext_vector_type(8)));
typedef float f32x4 __attribute__((ext_vector_type(4)));
typedef unsigned u32x4 __attribute__((ext_vector_type(4)));
constexpr int BM = 256, BK = 64, HALF = 128, HTB = HALF * BK * 2  , STAGE_BYTES = 8 * HTB, NXCD = 8, WGM = 8;

__host__ __device__ __forceinline__ int lds_byte(int r, int c) { const int st = (r >> 4) * 2 + (c >> 5), rr = r & 15, cc = c & 31, ob = rr * 64 + cc * 2; return st * 1024 + (ob ^ (((ob >> 9) & 1) << 5)); }
__host__ __device__ __forceinline__ void stage_rc(int b, int& R, int& C) { const int st = b / 1024, sb = b % 1024, swz = sb ^ (((sb >> 9) & 1) << 5); R = (st >> 1) * 16 + swz / 64; C = (st & 1) * 32 + (swz % 64) / 2; }
__host__ __device__ __forceinline__ int perm32(int rho) { const int n = rho >> 4, i = rho & 15; return 8 * (i >> 2) + 4 * n + (i & 3); }

struct Unit { int pm, pn; };
struct Gemm { const bf16_t* A; const bf16_t* Bt; int M, N, K; };

struct StaticOrder {
    int nM, nN, nwg, G, c;
    __host__ __device__ void init(int M, int N, int G_, int c_) { nM = M / BM; nN = N / BM; nwg = nM * nN; G = G_; c = c_; }
    __host__ __device__ bool next(int i, Unit& u) const {
        const long L = (long)i * G + c; if (L >= nwg) return false;
        int wgid = (int)L; { const int q = nwg / NXCD, r = nwg % NXCD, xcd = wgid % NXCD, off = wgid / NXCD; wgid = (xcd < r ? xcd * (q + 1) : r * (q + 1) + (xcd - r) * q) + off; }
        const int nig = WGM * nN, gid = wgid / nig, fm = gid * WGM, gsz = (nM - fm) < WGM ? (nM - fm) : WGM;
        u.pm = fm + ((wgid % nig) % gsz); u.pn = (wgid % nig) / gsz; return true;
    }
    __device__ __forceinline__ void a_ready(const Unit&) const {}
    __device__ __forceinline__ void done(const Unit&) const {}
};

__device__ __forceinline__ unsigned cvt_pk_bf16(float lo, float hi) { unsigned r; asm volatile("v_cvt_pk_bf16_f32 %0, %1, %2" : "=v"(r) : "v"(lo), "v"(hi)); return r; }
typedef float f32x2 __attribute__((ext_vector_type(2)));
template <class Epi, class Sched, bool ALIGN_EPI = false, bool SP2 = false>
__device__ __forceinline__ void gemm_phase(PG8_LAS unsigned char* lds, const Gemm g, const Sched& S, const Epi& E) {
    int tid_l = threadIdx.x; asm volatile("" : "+v"(tid_l));
    const int tid = tid_l, wid = __builtin_amdgcn_readfirstlane(tid >> 6), lane = tid & 63, wr = wid >> 2, wc = wid & 3, fr = lane & 15, fq = lane >> 4;
    const int K = g.K, nt = K / BK;
    unsigned voffA[2], voffB[2];
#pragma unroll
    for (int i = 0; i < 2; ++i) { int R, C; stage_rc(tid * 16 + i * 8192, R, C); const int Rb = Epi::PERM ? ((R & ~31) + perm32(R & 31)) : R;
        voffA[i] = (unsigned)(R * K + C) * 2u; voffB[i] = (unsigned)(Rb * K + C) * 2u; }
    const size_t kstep = (size_t)(BK * 2);
    const size_t hstep = (size_t)HALF * K * 2;
    const size_t tstep = 2 * hstep;
    const unsigned ldsw = (unsigned)wid * 1024u;
    const int aoff = lds_byte(wr * 64 + fr, fq * 8), boff = lds_byte(wc * 32 + fr, fq * 8);
#define PG8_SA(b, h) (((b) * 2 + (h)) * HTB)
#define PG8_SB(b, h) ((4 + (b) * 2 + (h)) * HTB)
#define PG8_STAGE(bufoff, gbase, voff) do { _Pragma("unroll") for (int _i = 0; _i < 2; ++_i) \
        __builtin_amdgcn_global_load_lds((const unsigned*)((const char*)(gbase) + (voff)[_i]), (PG8_LAS unsigned*)(lds + (bufoff) + ldsw + _i * 8192), 16, 0, 0); } while (0)
#define PG8_LDA(dst, b, h) do { _Pragma("unroll") for (int m = 0; m < 4; ++m) _Pragma("unroll") for (int k = 0; k < 2; ++k) dst[m][k] = *(const PG8_LAS bf16x8*)(lds + PG8_SA(b, h) + aoff + m * 2048 + k * 1024); } while (0)
#define PG8_LDB(dst, b, h) do { _Pragma("unroll") for (int n = 0; n < 2; ++n) _Pragma("unroll") for (int k = 0; k < 2; ++k) dst[n][k] = *(const PG8_LAS bf16x8*)(lds + PG8_SB(b, h) + boff + n * 2048 + k * 1024); } while (0)
#define PG8_MMA(ai, bj, At, Bt) do { __builtin_amdgcn_s_setprio(1); _Pragma("unroll") for (int m = 0; m < 4; ++m) _Pragma("unroll") for (int n = 0; n < 2; ++n) _Pragma("unroll") for (int k = 0; k < 2; ++k) \
        acc[ai][bj][m][n] = __builtin_amdgcn_mfma_f32_16x16x32_bf16(Bt[n][k], At[m][k], acc[ai][bj][m][n], 0, 0, 0); __builtin_amdgcn_s_setprio(0); } while (0)
#define PG8_WAIT_V(n) asm volatile("s_waitcnt vmcnt(" #n ")" ::: "memory")
#define PG8_WAIT_L(n) asm volatile("s_waitcnt lgkmcnt(" #n ")" ::: "memory")
#define PG8_BAR __builtin_amdgcn_s_barrier()
#define PG8_SCHED __builtin_amdgcn_sched_barrier(0)
    Unit cur, nxt; int ui = 0;
    if (!S.next(0, cur)) return;
    f32x4 acc[2][2][4][2];
#pragma unroll
    for (int a = 0; a < 2; ++a)
#pragma unroll
        for (int b = 0; b < 2; ++b)
#pragma unroll
            for (int m = 0; m < 4; ++m)
#pragma unroll
                for (int n = 0; n < 2; ++n) acc[a][b][m][n] = (f32x4){0.f, 0.f, 0.f, 0.f};
    bf16x8 At[4][2], B0[2][2], B1[2][2];
    const char* cA = (const char*)g.A + (size_t)cur.pm * tstep; const char* cB = (const char*)g.Bt + (size_t)cur.pn * tstep;
    S.a_ready(cur);
    if constexpr (SP2) {
        PG8_STAGE(PG8_SB(0, 0), cB, voffB); PG8_STAGE(PG8_SB(0, 1), cB + hstep, voffB); PG8_STAGE(PG8_SA(0, 0), cA, voffA); PG8_STAGE(PG8_SA(0, 1), cA + hstep, voffA);
        if (wr == 1) PG8_BAR;
        PG8_WAIT_V(2); PG8_BAR;
        PG8_STAGE(PG8_SB(1, 0), cB + kstep, voffB); PG8_STAGE(PG8_SA(1, 0), cA + kstep, voffA); PG8_STAGE(PG8_SB(1, 1), cB + hstep + kstep, voffB);
        PG8_WAIT_V(6); PG8_BAR;
    } else {
        PG8_STAGE(PG8_SB(0, 0), cB, voffB); PG8_STAGE(PG8_SA(0, 0), cA, voffA); PG8_STAGE(PG8_SB(0, 1), cB + hstep, voffB); PG8_STAGE(PG8_SA(0, 1), cA + hstep, voffA);
        if (wr == 1) PG8_BAR;
        PG8_WAIT_V(4); PG8_BAR;
        PG8_STAGE(PG8_SB(1, 0), cB + kstep, voffB); PG8_STAGE(PG8_SA(1, 0), cA + kstep, voffA); PG8_STAGE(PG8_SB(1, 1), cB + hstep + kstep, voffB);
        PG8_WAIT_V(6); PG8_BAR;
    }
    for (;;) {
        const bool has_next = S.next(ui + 1, nxt);
        const char* nA = has_next ? (const char*)g.A + (size_t)nxt.pm * tstep : cA; const char* nB = has_next ? (const char*)g.Bt + (size_t)nxt.pn * tstep : cB;
        for (int t = 0; t < nt; t += 2) {
            const bool last = (t == nt - 2);
            const char* a1 = cA + (size_t)(t + 1) * kstep;
            const char* a2 = last ? nA : cA + (size_t)(t + 2) * kstep; const char* b2 = last ? nB : cB + (size_t)(t + 2) * kstep;
            const char* a3 = a2 + kstep; const char* b3 = b2 + kstep;
            if (last && has_next) S.a_ready(nxt);
            if constexpr (SP2) {
            PG8_LDB(B0, 0, 0); PG8_LDB(B1, 0, 1); PG8_SCHED; PG8_LDA(At, 0, 0); PG8_STAGE(PG8_SA(1, 1), a1 + hstep, voffA);
            PG8_WAIT_V(8); PG8_WAIT_L(0); PG8_BAR; PG8_MMA(0, 0, At, B0); PG8_MMA(0, 1, At, B1); PG8_BAR; PG8_SCHED;
            PG8_LDA(At, 0, 1); PG8_STAGE(PG8_SB(0, 0), b2, voffB); PG8_STAGE(PG8_SB(0, 1), b2 + hstep, voffB); PG8_STAGE(PG8_SA(0, 0), a2, voffA);
            PG8_WAIT_V(8); PG8_WAIT_L(0); PG8_BAR; PG8_MMA(1, 0, At, B0); PG8_MMA(1, 1, At, B1); PG8_BAR; PG8_SCHED;
            PG8_LDB(B0, 1, 0); PG8_LDB(B1, 1, 1); PG8_SCHED; PG8_LDA(At, 1, 0); PG8_STAGE(PG8_SA(0, 1), a2 + hstep, voffA);
            PG8_WAIT_V(8); PG8_WAIT_L(0); PG8_BAR; PG8_MMA(0, 0, At, B0); PG8_MMA(0, 1, At, B1); PG8_BAR; PG8_SCHED;
            PG8_LDA(At, 1, 1); PG8_STAGE(PG8_SB(1, 0), b3, voffB); PG8_STAGE(PG8_SB(1, 1), b3 + hstep, voffB); PG8_STAGE(PG8_SA(1, 0), a3, voffA);
            PG8_WAIT_V(8); PG8_WAIT_L(0); PG8_BAR; PG8_MMA(1, 0, At, B0); PG8_MMA(1, 1, At, B1); PG8_BAR; PG8_SCHED;
            } else {
            PG8_LDB(B0, 0, 0); PG8_SCHED; PG8_LDA(At, 0, 0); PG8_STAGE(PG8_SA(1, 1), a1 + hstep, voffA);
            PG8_WAIT_L(8); PG8_BAR; PG8_WAIT_L(0); PG8_MMA(0, 0, At, B0); PG8_BAR; PG8_SCHED;
            PG8_LDB(B1, 0, 1); PG8_STAGE(PG8_SB(0, 0), b2, voffB);
            PG8_BAR; PG8_WAIT_L(0); PG8_MMA(0, 1, At, B1); PG8_BAR;
            PG8_LDA(At, 0, 1); PG8_STAGE(PG8_SA(0, 0), a2, voffA);
            PG8_BAR; PG8_WAIT_L(0); PG8_MMA(1, 0, At, B0); PG8_BAR; PG8_SCHED;
            PG8_STAGE(PG8_SB(0, 1), b2 + hstep, voffB);
            PG8_WAIT_V(6); PG8_BAR; PG8_MMA(1, 1, At, B1); PG8_BAR;
            PG8_LDB(B0, 1, 0); PG8_SCHED; PG8_LDA(At, 1, 0); PG8_STAGE(PG8_SA(0, 1), a2 + hstep, voffA);
            PG8_WAIT_L(8); PG8_BAR; PG8_WAIT_L(0); PG8_MMA(0, 0, At, B0); PG8_BAR; PG8_SCHED;
            PG8_LDB(B1, 1, 1); PG8_STAGE(PG8_SB(1, 0), b3, voffB);
            PG8_BAR; PG8_WAIT_L(0); PG8_MMA(0, 1, At, B1); PG8_BAR;
            PG8_LDA(At, 1, 1); PG8_STAGE(PG8_SA(1, 0), a3, voffA);
            PG8_BAR; PG8_WAIT_L(0); PG8_MMA(1, 0, At, B0); PG8_BAR; PG8_SCHED;
            PG8_STAGE(PG8_SB(1, 1), b3 + hstep, voffB);
            PG8_WAIT_V(6); PG8_BAR; PG8_MMA(1, 1, At, B1); PG8_BAR;
            }
        }
        if constexpr (ALIGN_EPI) { if (wr == 0) PG8_BAR; }
        if constexpr (!Epi::AFTER_DRAIN) { E(acc, cur, wr, wc, fr, fq); S.done(cur); }
        if (!has_next) break;
#pragma unroll
        for (int a = 0; a < 2; ++a)
#pragma unroll
            for (int b = 0; b < 2; ++b)
#pragma unroll
                for (int m = 0; m < 4; ++m)
#pragma unroll
                    for (int n = 0; n < 2; ++n) acc[a][b][m][n] = (f32x4){0.f, 0.f, 0.f, 0.f};
        cur = nxt; cA = nA; cB = nB; ++ui;
        if constexpr (ALIGN_EPI) { if (wr == 1) PG8_BAR; }
    }
    PG8_WAIT_V(0);
    if constexpr (!ALIGN_EPI) { if (wr == 0) PG8_BAR; }
    PG8_BAR;
    if constexpr (Epi::AFTER_DRAIN) { E.fused(acc, cur, wr, wc, fr, fq, lds, wid, lane); S.done(cur); }
#undef PG8_SA
#undef PG8_SB
#undef PG8_STAGE
#undef PG8_LDA
#undef PG8_LDB
#undef PG8_MMA
#undef PG8_WAIT_V
#undef PG8_WAIT_L
#undef PG8_BAR
#undef PG8_SCHED
}
}

namespace pg8 {
typedef unsigned u32x2 __attribute__((ext_vector_type(2)));
__device__ __forceinline__ int midx_of(int pm) { return (pm % 9 == 8) ? 8 : (pm / 9); }
struct PanelOrder {
    StaticOrder so; int lat;
    __device__ void init(int N, int G_, int c_, int lat_only) { lat = lat_only; so.init(lat_only ? 64 * BM : 72 * BM, N, G_, c_); }
    __device__ bool next(int i, Unit& u) const { if (!so.next(i, u)) return false; if (lat) u.pm = (u.pm >> 3) * 9 + (u.pm & 7); return true; }
    __device__ __forceinline__ void a_ready(const Unit&) const {}
    __device__ __forceinline__ void done(const Unit&) const {}
};
__device__ __forceinline__ float silu_f(float g) { return g * __builtin_amdgcn_rcpf(1.0f + __builtin_amdgcn_exp2f(-1.4426950408889634f * g)); }
struct EpiSwiGLU {
    static constexpr bool PERM = true, AFTER_DRAIN = false;
    bf16_t* O; int ldc;
    __device__ __forceinline__ void operator()(const f32x4 (&acc)[2][2][4][2], const Unit& u, int wr, int wc, int fr, int fq) const {
        const int row0 = u.pm * BM + wr * 64 + fr, col0 = u.pn * HALF + wc * 32 + 8 * fq;
#pragma unroll
        for (int ai = 0; ai < 2; ++ai)
#pragma unroll
            for (int m = 0; m < 4; ++m) {
                bf16_t* p = O + (size_t)(row0 + ai * HALF + m * 16) * ldc + col0;
                const f32x4 g0 = acc[ai][0][m][0], g1 = acc[ai][0][m][1], u0 = acc[ai][1][m][0], u1 = acc[ai][1][m][1];
                u32x4 w;
                w.x = cvt_pk_bf16(silu_f(g0[0]) * u0[0], silu_f(g0[1]) * u0[1]);
                w.y = cvt_pk_bf16(silu_f(g0[2]) * u0[2], silu_f(g0[3]) * u0[3]);
                w.z = cvt_pk_bf16(silu_f(g1[0]) * u1[0], silu_f(g1[1]) * u1[1]);
                w.w = cvt_pk_bf16(silu_f(g1[2]) * u1[2], silu_f(g1[3]) * u1[3]);
                *(u32x4*)p = w;
            }
    }
};
struct EpiResid {
    static constexpr bool PERM = false, AFTER_DRAIN = false;
    float* X; const float* gate; float gs;
    __device__ __forceinline__ void operator()(const f32x4 (&acc)[2][2][4][2], const Unit& u, int wr, int wc, int fr, int fq) const {
        const int midx = (u.pm % 9 == 8) ? 8 : (u.pm / 9);
        const float* gp = gate + midx * 9216;
        const int row0 = u.pm * BM + wr * 64 + fr, col0 = u.pn * BM + wc * 32 + 4 * fq;
#pragma unroll
        for (int bj = 0; bj < 2; ++bj)
#pragma unroll
            for (int n = 0; n < 2; ++n) {
                const f32x4 gv = *(const f32x4*)(gp + col0 + bj * HALF + n * 16) * gs;
#pragma unroll
                for (int ai = 0; ai < 2; ++ai)
#pragma unroll
                    for (int m = 0; m < 4; ++m) {
                        float* p = X + (size_t)(row0 + ai * HALF + m * 16) * 1024 + col0 + bj * HALF + n * 16;
                        f32x4 x = *(const f32x4*)p; x += gv * acc[ai][bj][m][n]; *(f32x4*)p = x;
                    }
                asm volatile("" ::: "memory");
            }
    }
};
struct EpiStore {
    static constexpr bool PERM = true, AFTER_DRAIN = false;
    bf16_t* O; int ldc;
    __device__ __forceinline__ void operator()(const f32x4 (&acc)[2][2][4][2], const Unit& u, int wr, int wc, int fr, int fq) const {
        const int row0 = u.pm * BM + wr * 64 + fr, col0 = u.pn * BM + wc * 32 + 8 * fq;
#pragma unroll
        for (int ai = 0; ai < 2; ++ai)
#pragma unroll
            for (int m = 0; m < 4; ++m) {
                bf16_t* p = O + (size_t)(row0 + ai * HALF + m * 16) * ldc + col0;
#pragma unroll
                for (int bj = 0; bj < 2; ++bj) {
                    const f32x4 v0 = acc[ai][bj][m][0], v1 = acc[ai][bj][m][1];
                    u32x4 w; w.x = cvt_pk_bf16(v0[0], v0[1]); w.y = cvt_pk_bf16(v0[2], v0[3]); w.z = cvt_pk_bf16(v1[0], v1[1]); w.w = cvt_pk_bf16(v1[2], v1[3]);
                    *(u32x4*)(p + bj * HALF) = w;
                }
            }
    }
};
}

#define LAS __attribute__((address_space(3)))
typedef unsigned short bf16_t;
typedef short bf16x8 __attribute__((ext_vector_type(8)));
typedef short s16x4 __attribute__((ext_vector_type(4)));
typedef float f32x4 __attribute__((ext_vector_type(4)));
typedef float f32x16 __attribute__((ext_vector_type(16)));
typedef unsigned u32x4 __attribute__((ext_vector_type(4)));
typedef unsigned u32x2 __attribute__((ext_vector_type(2)));

constexpr int D = 1024, NB = 8, SEQ = 2048, CTX = 256, TPB = SEQ + CTX  , T = NB * TPB  ;
constexpr int DFF = 2816, NMOD = 9, MODW = NMOD * D  ;
constexpr float EPS = 1e-6f, LOG2E = 1.4426950408889634f;
constexpr int LDS_BYTES = 147456;

constexpr size_t al(size_t x) { return (x + 255) & ~(size_t)255; }
constexpr size_t WS_CTL = 0;
constexpr size_t WS_MOD = 16384;
constexpr size_t WS_X = al(WS_MOD + (size_t)4 * 9 * MODW * 4);
constexpr size_t WS_H = al(WS_X + (size_t)T * D * 4);
constexpr size_t WS_ACT = al(WS_H + (size_t)T * D * 2);
constexpr size_t WS_QKV = al(WS_ACT + (size_t)T * DFF * 2);
constexpr size_t WS_O = al(WS_QKV + (size_t)T * 3072 * 2);
constexpr size_t WS_WIN = al(WS_O + (size_t)T * D * 2);
constexpr size_t WS_WOUT = al(WS_WIN + (size_t)8 * 5632 * 1024 * 2);
constexpr size_t WS_WA_QKV = al(WS_WOUT + (size_t)8 * 1024 * 2816 * 2);
constexpr size_t WS_WA_O = al(WS_WA_QKV + (size_t)3072 * 1024 * 2);
constexpr size_t WS_WB_QKV = al(WS_WA_O + (size_t)1024 * 1024 * 2);
constexpr size_t WS_WB_O = al(WS_WB_QKV + (size_t)1536 * 1024 * 2);
constexpr size_t WS_WC_DOWN = al(WS_WB_O + (size_t)1024 * 1024 * 2);
constexpr size_t WS_WC_UQ = al(WS_WC_DOWN + (size_t)512 * 1024 * 2);
constexpr size_t WS_WC_UKV = al(WS_WC_UQ + (size_t)1536 * 256 * 2);
constexpr size_t WS_WC_O = al(WS_WC_UKV + (size_t)2048 * 128 * 2);
constexpr size_t WS_WD_QKV = al(WS_WC_O + (size_t)1024 * 1024 * 2);
constexpr size_t WS_WD_O = al(WS_WD_QKV + (size_t)3072 * 1024 * 2);
constexpr size_t WS_END = al(WS_WD_O + (size_t)1024 * 1024 * 2);
constexpr size_t WS_QM = WS_QKV;
constexpr size_t WS_DOWN = al(WS_QM + (size_t)T * 1536 * 2);
constexpr size_t WS_CQN = al(WS_DOWN + (size_t)T * 512 * 2);
constexpr size_t WS_CKVN = al(WS_CQN + (size_t)T * 256 * 2);
constexpr size_t WS_KPE = al(WS_CKVN + (size_t)T * 128 * 2);
static_assert(WS_KPE + (size_t)T * 32 * 2 <= WS_O, "MLA buffers fit in the QKV region");
constexpr size_t WS_KVM = WS_ACT;
static_assert((size_t)T * 2048 * 2 <= (size_t)T * DFF * 2, "KVM fits in ACT");

struct Args { const float* in[30]; float* out; unsigned char* ws; };

__device__ __forceinline__ float wave_sum(float v) {
#pragma unroll
    for (int o = 1; o < 64; o <<= 1) v += __shfl_xor(v, o);
    return v;
}
__device__ __forceinline__ unsigned f2bf(float f) { unsigned u = __builtin_bit_cast(unsigned, f); return (u + 0x7fffu + ((u >> 16) & 1u)) >> 16; }
typedef float f32x2_t __attribute__((ext_vector_type(2))); typedef __bf16 bf16x2_t __attribute__((ext_vector_type(2)));
__device__ __forceinline__ unsigned pk2(float lo, float hi) { f32x2_t v = {lo, hi}; bf16x2_t r = __builtin_convertvector(v, bf16x2_t); return __builtin_bit_cast(unsigned, r); }
__device__ __forceinline__ float bf_lo(unsigned w) { return __builtin_bit_cast(float, w << 16); }
__device__ __forceinline__ float bf_hi(unsigned w) { return __builtin_bit_cast(float, w & 0xffff0000u); }
__device__ __forceinline__ void rope_cs(int pos, int j, float log2theta_over_nf, float& c, float& s) {
    const float inv = __builtin_amdgcn_exp2f(-(float)j * log2theta_over_nf);
    const float ang = (float)pos * inv;
    c = __cosf(ang); s = __sinf(ang);
}
constexpr float L2T = 13.287712379549449f;

__device__ __forceinline__ void transpose_item(const float* W, int K, int N, bf16_t* WT, int k0, int n0, int dst_row0, LAS float* scr, int lane) {
#pragma unroll 8
    for (int i = 0; i < 32; ++i) { const int kk = 2 * i + (lane >> 5); scr[kk * 33 + (lane & 31)] = W[(size_t)(k0 + kk) * N + n0 + (lane & 31)]; }
    asm volatile("s_waitcnt lgkmcnt(0)" ::: "memory");
    const int c = lane & 7;
#pragma unroll
    for (int j = 0; j < 4; ++j) { const int n = (lane >> 3) + 8 * j; const LAS float* s = scr + (8 * c) * 33 + n;
        u32x4 o; o.x = pk2(s[0 * 33], s[1 * 33]); o.y = pk2(s[2 * 33], s[3 * 33]); o.z = pk2(s[4 * 33], s[5 * 33]); o.w = pk2(s[6 * 33], s[7 * 33]);
        *(u32x4*)(WT + (size_t)(dst_row0 + n) * K + k0 + 8 * c) = o; }
    asm volatile("s_waitcnt lgkmcnt(0)" ::: "memory");
}
__device__ __forceinline__ void conv_item_plain(const float* W, int K, int N, bf16_t* WT, int item, LAS float* scr, int lane) {
    const int nblk = N / 32, kb = item / nblk, nb = item % nblk;
    transpose_item(W, K, N, WT, 64 * kb, 32 * nb, 32 * nb, scr, lane);
}

__device__ __forceinline__ void norm_phase(const float* X, const float* g, const float* modl, int shift_idx, int scale_idx, bf16_t* H, int gw, int ngw, int lane) {
    for (int row = gw; row < T; row += ngw) {
        const int b = row / TPB, t = row - b * TPB, midx = (t >= SEQ) ? 8 : b;
        const float* mp = modl + midx * MODW;
        const f32x4* xr = (const f32x4*)(X + (size_t)row * D) + lane;
        f32x4 v[4]; float ss = 0.f;
#pragma unroll
        for (int j = 0; j < 4; ++j) { v[j] = xr[64 * j]; ss += (v[j].x * v[j].x + v[j].y * v[j].y) + (v[j].z * v[j].z + v[j].w * v[j].w); }
        const float r = 1.0f / sqrtf(wave_sum(ss) * (1.0f / D) + EPS);
        u32x2* o8 = (u32x2*)(H + (size_t)row * D) + lane;
#pragma unroll
        for (int j = 0; j < 4; ++j) {
            const int col = 4 * (lane + 64 * j);
            const f32x4 gg = *(const f32x4*)(g + col), sc = *(const f32x4*)(mp + scale_idx * D + col), sh = *(const f32x4*)(mp + shift_idx * D + col);
            const f32x4 y = (v[j] * r * gg) * (sc + 1.0f) + sh;
            u32x2 w; w.x = pk2(y.x, y.y); w.y = pk2(y.z, y.w); o8[64 * j] = w;
        }
    }
}

template <int MODE> struct ACfg;
template <> struct ACfg<0> { static constexpr int KW = 128, DQK = 64, DV = 128; };
template <> struct ACfg<1> { static constexpr int KW = 64, DQK = 64, DV = 64; };
template <> struct ACfg<2> { static constexpr int KW = 96, DQK = 96, DV = 64; };
template <> struct ACfg<3> { static constexpr int KW = 64, DQK = 64, DV = 64; };
struct AttnP { const bf16_t* q; const bf16_t* k; const bf16_t* k2; const bf16_t* v; bf16_t* o; int ldq, ldk, ldv; const float* rpb; float lam; const float* subln; float c; };
__device__ __forceinline__ int crow(int r, int hi) { return (r & 3) + 8 * (r >> 2) + 4 * hi; }
#define MFMA32(a, b, c) __builtin_amdgcn_mfma_f32_32x32x16_bf16((a), (b), (c), 0, 0, 0)

template <int MODE>
__device__ __forceinline__ void attn_phase(LAS unsigned char* lds, const AttnP P, int vcu, int G) {
    using C = ACfg<MODE>;
    constexpr int KW = C::KW, DQK = C::DQK, DV = C::DV;
    constexpr int RSK = (KW + 8) * 2, RSV = 136, KBUF = 64 * RSK, VBUF = DV * RSV;
    constexpr int OFFV = 2 * KBUF, OFFR = 2 * KBUF + 2 * VBUF;
    constexpr int NQS = DQK / 16, NDB = DV / 32;
    constexpr int KPR = KW / 8, NCK = 64 * KPR, KCH = (NCK + 511) / 512;
    constexpr int VPR = DV / 8, NCV = 32 * VPR;
    static_assert(OFFR + 465 * 4 <= 131072, "attention LDS");
    int tid_l = threadIdx.x; asm volatile("" : "+v"(tid_l));
    const int tid = tid_l, lane = tid & 63, l31 = lane & 31, hi = lane >> 5;
    const int wid = __builtin_amdgcn_readfirstlane(tid >> 6);
    constexpr int NLAT = 1024, NCTX = (MODE == 3) ? 0 : 128;
    LAS float* rpbL = (LAS float*)(lds + OFFR);
    for (int u = vcu; u < NLAT + NCTX; u += G) {
        int b, hh, qbase, t0, n0, t1 = 0, n1 = 0;
        if (u < NLAT) {
            if (MODE == 0) { qbase = (u & 15) * 128; hh = (u >> 4) & 7; }
            else if (MODE == 1) { qbase = (u & 31) * 64; hh = (u >> 5) & 3; }
            else { qbase = (u & 7) * 256; hh = (u >> 3) & 15; }
            b = u >> 7; t0 = 0; n0 = 36;
            if (MODE == 3) { t0 = 32; n0 = 4; const int r0 = (u & 7) * 4; const int jlo = min(max(r0 - 4, 0), 24), jhi = min(max(r0 - 1, 0), 24) + 7; t1 = jlo; n1 = jhi - jlo + 1; }
        } else {
            const int uu = u - NLAT; b = uu >> 4; t0 = 32; n0 = 4;
            if (MODE == 0) { qbase = SEQ + (uu & 1) * 128; hh = (uu >> 1) & 7; }
            else if (MODE == 1) { qbase = SEQ + (uu & 3) * 64; hh = (uu >> 2) & 3; }
            else { qbase = SEQ; hh = uu & 15; }
        }
        int qloc, qcol, kcol, vcol, ocol, koff = 0;
        if (MODE == 0) { const int m = wid >> 2; qloc = (wid & 3) * 32 + l31; qcol = hh * 128 + m * 64; kcol = 1024 + hh * 128; vcol = 2048 + hh * 128; ocol = hh * 128; koff = m * 64; }
        else if (MODE == 1) { const int g = wid >> 1; qloc = (wid & 1) * 32 + l31; qcol = (hh * 4 + g) * 64; kcol = 1024 + hh * 64; vcol = 1280 + hh * 64; ocol = qcol; }
        else if (MODE == 2) { qloc = wid * 32 + l31; qcol = hh * 96; kcol = hh * 128; vcol = hh * 128 + 64; ocol = hh * 64; }
        else { qloc = wid * 32 + l31; qcol = hh * 64; kcol = 1024 + hh * 64; vcol = 2048 + hh * 64; ocol = hh * 64; }
        const size_t rb = (size_t)b * TPB;
        const size_t qrow = rb + qbase + qloc;
        bf16x8 qf[NQS];
#pragma unroll
        for (int st = 0; st < NQS; ++st) qf[st] = *(const bf16x8*)(P.q + qrow * P.ldq + qcol + st * 16 + hi * 8);
        const int gr = (qbase >> 6) + (wid >> 1), qc = (wid & 1) * 32 + l31;
        const int rs = min(max(gr - 4, 0), 24), cs = min(max(qc - 8, 0), 48);
        if (MODE == 3) { for (int i = tid; i < 465; i += 512) rpbL[i] = P.rpb[hh * 465 + i] * LOG2E; }

        u32x4 kreg[KCH], vreg[2];
#define ATT_LOAD(tile) do { const size_t krow0 = rb + (size_t)(tile) * 64; \
        _Pragma("unroll") for (int i = 0; i < KCH; ++i) { const int c_ = tid + 512 * i; if (c_ < NCK) { const int key = c_ / KPR, part = c_ % KPR; \
            const bf16_t* src = (MODE == 2 && part >= 8) ? (P.k2 + (krow0 + key) * 32 + (part - 8) * 8) : (P.k + (krow0 + key) * P.ldk + kcol + part * 8); \
            kreg[i] = *(const u32x4*)src; } } \
        if (tid < NCV) { const int pr = tid / VPR, dp = tid % VPR; const bf16_t* src = P.v + (krow0 + 2 * pr) * P.ldv + vcol + dp * 8; \
            vreg[0] = *(const u32x4*)src; vreg[1] = *(const u32x4*)(src + P.ldv); } } while (0)
#define ATT_WRITE(buf) do { \
        _Pragma("unroll") for (int i = 0; i < KCH; ++i) { const int c_ = tid + 512 * i; if (c_ < NCK) { const int key = c_ / KPR, part = c_ % KPR; \
            *(LAS u32x4*)(lds + (buf) * KBUF + key * RSK + part * 16) = kreg[i]; } } \
        if (tid < NCV) { const int pr = tid / VPR, dp = tid % VPR; LAS unsigned char* vb = lds + OFFV + (buf) * VBUF + (dp * 8) * RSV + pr * 4; \
            _Pragma("unroll") for (int e = 0; e < 4; ++e) { const unsigned a = vreg[0][e], bq = vreg[1][e]; \
                *(LAS unsigned*)(vb + (2 * e) * RSV) = (a & 0xffffu) | (bq << 16); \
                *(LAS unsigned*)(vb + (2 * e + 1) * RSV) = (a >> 16) | (bq & 0xffff0000u); } } } while (0)

        ATT_LOAD(t0);
        ATT_WRITE(0);
        __syncthreads();
        float m_run = -1e30f, l_run = 0.f;
        f32x16 o[NDB];
#pragma unroll
        for (int d = 0; d < NDB; ++d)
#pragma unroll
            for (int r = 0; r < 16; ++r) o[d][r] = 0.f;
        const int nt = n0 + n1;
        for (int it = 0; it < nt; ++it) {
            const int cur = it & 1;
            if (it + 1 < nt) { const int tn = (it + 1 < n0) ? (t0 + it + 1) : (t1 + (it + 1 - n0)); ATT_LOAD(tn); }
            bool active = true; int jrow = 0;
            const bool nbt = (MODE == 3) && (it >= n0);
            if (nbt) { jrow = t1 + it - n0; active = (jrow >= rs) && (jrow < rs + 8); }
            if (active) {
                const LAS unsigned char* kb_ = lds + cur * KBUF;
                const LAS unsigned char* vb_ = lds + OFFV + cur * VBUF;
                f32x16 s[2];
#pragma unroll
                for (int kb = 0; kb < 2; ++kb) {
#pragma unroll
                    for (int r = 0; r < 16; ++r) s[kb][r] = 0.f;
#pragma unroll
                    for (int st = 0; st < NQS; ++st) {
                        const bf16x8 kf = *(const LAS bf16x8*)(kb_ + (kb * 32 + l31) * RSK + (koff + st * 16 + hi * 8) * 2);
                        s[kb] = MFMA32(kf, qf[st], s[kb]);
                    }
                    if (NDB > 2) __builtin_amdgcn_sched_barrier(0);
                }
                float mx = -1e30f;
                if (nbt) {
                    const int ridx = (jrow - gr + 7) * 31;
#pragma unroll
                    for (int kb = 0; kb < 2; ++kb)
#pragma unroll
                        for (int r = 0; r < 16; ++r) {
                            const int cc = kb * 32 + crow(r, hi);
                            const int cidx = min(max(cc - qc + 15, 0), 30);
                            const bool valid = (cc >= cs) && (cc < cs + 16);
                            const float tv = valid ? (s[kb][r] * P.c + rpbL[ridx + cidx]) : -1e30f;
                            s[kb][r] = tv; mx = fmaxf(mx, tv);
                        }
                } else {
#pragma unroll
                    for (int kb = 0; kb < 2; ++kb)
#pragma unroll
                        for (int r = 0; r < 16; ++r) mx = fmaxf(mx, s[kb][r]);
                    mx *= P.c;
                }
                mx = fmaxf(mx, __shfl_xor(mx, 32));
                const float m_new = fmaxf(m_run, mx);
                const float alpha = __builtin_amdgcn_exp2f(m_run - m_new);
                m_run = m_new;
                float ps = 0.f;
                if (nbt) {
#pragma unroll
                    for (int kb = 0; kb < 2; ++kb)
#pragma unroll
                        for (int r = 0; r < 16; ++r) { const float pv = __builtin_amdgcn_exp2f(s[kb][r] - m_new); s[kb][r] = pv; ps += pv; }
                } else {
#pragma unroll
                    for (int kb = 0; kb < 2; ++kb)
#pragma unroll
                        for (int r = 0; r < 16; ++r) { const float pv = __builtin_amdgcn_exp2f(__builtin_fmaf(s[kb][r], P.c, -m_new)); s[kb][r] = pv; ps += pv; }
                }
                l_run = l_run * alpha + ps;
#pragma unroll
                for (int d = 0; d < NDB; ++d)
#pragma unroll
                    for (int r = 0; r < 16; ++r) o[d][r] *= alpha;
                bf16x8 pf[2][2];
#pragma unroll
                for (int kb = 0; kb < 2; ++kb)
#pragma unroll
                    for (int sl = 0; sl < 2; ++sl) {
                        u32x4 w;
                        w.x = pk2(s[kb][8 * sl + 0], s[kb][8 * sl + 1]); w.y = pk2(s[kb][8 * sl + 2], s[kb][8 * sl + 3]);
                        w.z = pk2(s[kb][8 * sl + 4], s[kb][8 * sl + 5]); w.w = pk2(s[kb][8 * sl + 6], s[kb][8 * sl + 7]);
                        pf[kb][sl] = __builtin_bit_cast(bf16x8, w);
                    }
#pragma unroll
                for (int d = 0; d < NDB; ++d) {
#pragma unroll
                    for (int kb = 0; kb < 2; ++kb)
#pragma unroll
                        for (int sl = 0; sl < 2; ++sl) {
                            const LAS unsigned char* vp = vb_ + (d * 32 + l31) * RSV + (kb * 32 + sl * 16 + hi * 4) * 2;
                            const s16x4 lo = *(const LAS s16x4*)vp, hi4 = *(const LAS s16x4*)(vp + 16);
                            const bf16x8 va = __builtin_shufflevector(lo, hi4, 0, 1, 2, 3, 4, 5, 6, 7);
                            o[d] = MFMA32(va, pf[kb][sl], o[d]);
                        }
                    if (NDB > 2) __builtin_amdgcn_sched_barrier(0);
                }
            }
            if (it + 1 < nt) ATT_WRITE(cur ^ 1);
            __syncthreads();
        }
        const float lt = l_run + __shfl_xor(l_run, 32);
        const float inv = 1.0f / lt;
        int lane_e = threadIdx.x & 63; asm volatile("" : "+v"(lane_e));
        const int hi_e = lane_e >> 5, l31_e = lane_e & 31;
        int qloc_e;
        if (MODE == 0) qloc_e = (wid & 3) * 32 + l31_e; else if (MODE == 1) qloc_e = (wid & 1) * 32 + l31_e; else qloc_e = wid * 32 + l31_e;
        bf16_t* op = P.o + (rb + qbase + qloc_e) * D + ocol;
        if (MODE != 0) {
#pragma unroll
            for (int d = 0; d < NDB; ++d)
#pragma unroll
                for (int g4 = 0; g4 < 4; ++g4) {
                    u32x2 w; w.x = pk2(o[d][4 * g4] * inv, o[d][4 * g4 + 1] * inv); w.y = pk2(o[d][4 * g4 + 2] * inv, o[d][4 * g4 + 3] * inv);
                    *(u32x2*)(op + d * 32 + 8 * g4 + 4 * hi_e) = w;
                }
        } else {
            LAS float* comb = (LAS float*)lds;
            if (wid >= 4) {
#pragma unroll
                for (int d = 0; d < NDB; ++d)
#pragma unroll
                    for (int r = 0; r < 16; ++r) comb[(((wid - 4) * 64 + d * 16 + r) * 64) + lane_e] = o[d][r] * inv;
            }
            __syncthreads();
            if (wid < 4) {
                float ss = 0.f;
#pragma unroll
                for (int d = 0; d < NDB; ++d) {
#pragma unroll
                    for (int r = 0; r < 16; ++r) { const float v = o[d][r] * inv - P.lam * comb[((wid * 64 + d * 16 + r) * 64) + lane_e]; o[d][r] = v; ss += v * v; }
                    __builtin_amdgcn_sched_barrier(0);
                }
                ss += __shfl_xor(ss, 32);
                const float rn = (1.0f / sqrtf(ss * (1.0f / 128.0f) + EPS)) * 0.8f;
#pragma unroll
                for (int d = 0; d < NDB; ++d)
#pragma unroll
                    for (int g4 = 0; g4 < 4; ++g4) {
                        const int dd = d * 32 + 8 * g4 + 4 * hi_e;
                        const f32x4 gg = *(const f32x4*)(P.subln + dd);
                        u32x2 w; w.x = pk2(o[d][4 * g4] * rn * gg.x, o[d][4 * g4 + 1] * rn * gg.y); w.y = pk2(o[d][4 * g4 + 2] * rn * gg.z, o[d][4 * g4 + 3] * rn * gg.w);
                        *(u32x2*)(op + dd) = w;
                        __builtin_amdgcn_sched_barrier(0);
                    }
            }
            __syncthreads();
        }
#undef ATT_LOAD
#undef ATT_WRITE
    }
}

#define XB_TMO      128
#define XB_XCNT(j)  (256  + 64 * (j))
#define XB_XSUB(j)  (1280 + 64 * (j))
#define XB_XGEN(j)  (2304 + 64 * (j))
#define XB_TOP      3328
#define XB_TOPGEN   3392
#define XCD_BAR_WORDS 3456
#define XB_SPIN_CAP (1u << 18)

__device__ __forceinline__ unsigned xb_ld(unsigned* p)              { return __hip_atomic_load(p, __ATOMIC_RELAXED, __HIP_MEMORY_SCOPE_AGENT); }
__device__ __forceinline__ unsigned xb_add(unsigned* p, unsigned v) { return __hip_atomic_fetch_add(p, v, __ATOMIC_RELAXED, __HIP_MEMORY_SCOPE_AGENT); }
__device__ __forceinline__ unsigned xb_xcc_id() { return (unsigned)__builtin_amdgcn_s_getreg((3 << 11) | 20) & 0xFu; }
#define XB_SPIN(cond, bar) do { unsigned _sp = 0; while (cond) { __builtin_amdgcn_s_sleep(1); \
    if ((++_sp & 255u) == 0u) { if (xb_ld(&(bar)[XB_TMO])) break; if (_sp > XB_SPIN_CAP) { atomicAdd(&(bar)[XB_TMO], 1u); break; } } } } while (0)

struct XcdBarrier {
    unsigned* bar; unsigned x;
    volatile LAS unsigned* st;
};

__device__ __forceinline__ XcdBarrier xcd_barrier_post(unsigned* bar, volatile LAS unsigned* st) {
    XcdBarrier b; b.bar = bar; b.x = xb_xcc_id(); b.st = st;
    if (threadIdx.x == 0) (void)xb_add(&bar[XB_XCNT(b.x)], 1u);
    return b;
}
__device__ __forceinline__ void xcd_barrier_complete(unsigned* bar, unsigned x, unsigned& nloc, unsigned& nx) {
    const unsigned G = gridDim.x * gridDim.y * gridDim.z;
    unsigned sum, cnt, mine, sp = 0u;
    for (;;) {
        sum = 0u; cnt = 0u; mine = 0u;
#pragma unroll
        for (unsigned j = 0; j < 16; ++j) { const unsigned c = xb_ld(&bar[XB_XCNT(j)]); sum += c; cnt += (c > 0u) ? 1u : 0u; mine = (j == x) ? c : mine; }
        if (sum == G) break;
        __builtin_amdgcn_s_sleep(1);
        if ((++sp & 255u) == 0u) { if (xb_ld(&bar[XB_TMO])) break; if (sp > XB_SPIN_CAP) { atomicAdd(&bar[XB_TMO], 1u); break; } }
    }
    nloc = mine > 0u ? mine : 1u; nx = cnt > 0u ? cnt : 1u;
}

__device__ __forceinline__ void xcd_barrier(const XcdBarrier& b) {
    asm volatile("s_waitcnt vmcnt(0)" ::: "memory");
    __syncthreads();
    if (threadIdx.x == 0) {
        unsigned* bar = b.bar;
        __builtin_amdgcn_s_waitcnt(0);
        unsigned nloc = b.st[0], nx = b.st[1];
        if (nloc == 0u) { xcd_barrier_complete(bar, b.x, nloc, nx); b.st[0] = nloc; b.st[1] = nx; }
        const unsigned old = xb_add(&bar[XB_XSUB(b.x)], 1u);
        const unsigned gen = old / nloc;
        if (old + 1u == (gen + 1u) * nloc) {
            __builtin_amdgcn_fence(__ATOMIC_RELEASE, "agent");
            asm volatile("s_waitcnt vmcnt(0)" ::: "memory");
            const unsigned og = xb_add(&bar[XB_TOP], 1u);
            const unsigned tg = og / nx;
            if (og + 1u == (tg + 1u) * nx) xb_add(&bar[XB_TOPGEN], 1u);
            else XB_SPIN(xb_ld(&bar[XB_TOPGEN]) == tg, bar);
            __builtin_amdgcn_fence(__ATOMIC_ACQUIRE, "agent");
            xb_add(&bar[XB_XGEN(b.x)], 1u);
            asm volatile("s_waitcnt vmcnt(0)" ::: "memory");
        } else {
            XB_SPIN(xb_ld(&bar[XB_XGEN(b.x)]) == gen, bar);
            __builtin_amdgcn_fence(__ATOMIC_ACQUIRE, "agent");
            asm volatile("s_waitcnt vmcnt(0)" ::: "memory");
        }
    }
    __syncthreads();
}

#ifndef MEGA
#define MEGA 1
#endif
#define CAS __attribute__((address_space(4)))
#define GET_ARGS const CAS Args* ap_ = (const CAS Args*)__builtin_amdgcn_kernarg_segment_ptr(); asm volatile("" : "+s"(ap_)); const CAS Args& a = *ap_
struct Ids { int tid, lane, wid, G, bx, vcu, gw, ngw, gt, ngt; };
__device__ __forceinline__ Ids make_ids() {
    Ids I; { int t_ = threadIdx.x; asm volatile("" : "+v"(t_)); I.tid = t_; } I.lane = I.tid & 63; I.wid = __builtin_amdgcn_readfirstlane(I.tid >> 6);
    { int g_ = gridDim.x, b_ = blockIdx.x; asm volatile("" : "+s"(g_), "+s"(b_)); I.G = g_; I.bx = b_; } I.vcu = (I.G % 8 == 0) ? (I.bx % 8) * (I.G / 8) + I.bx / 8 : I.bx;
    I.gw = I.bx * 8 + I.wid; I.ngw = I.G * 8; I.gt = I.bx * 512 + I.tid; I.ngt = I.G * 512; return I;
}

__device__ __forceinline__ void ph_prologue(LAS unsigned char* lds) { GET_ARGS;
    const Ids I = make_ids(); const int tid = I.tid, lane = I.lane, wid = I.wid, G = I.G, bx = I.bx;
    unsigned char* ws = a.ws;
    float* MOD = (float*)(ws + WS_MOD); float* X = (float*)(ws + WS_X);
    bf16_t* WIN = (bf16_t*)(ws + WS_WIN); bf16_t* WOUT = (bf16_t*)(ws + WS_WOUT);
    LAS float* S = (LAS float*)lds;
    LAS float* RED = (LAS float*)(lds + 36864);
    for (int i = tid; i < 9 * D; i += 512) { const int r = i >> 10, k = i & 1023; const float v = (r < 8) ? a.in[1][r * D + k] : a.in[3][k]; S[i] = v / (1.0f + __expf(-v)); }
    __syncthreads();
    for (int item = bx; item < 4 * 72; item += G) {
        const int layer = item / 72, cb = (item % 72) * 128;
        const float* w = a.in[4] + (size_t)layer * D * MODW + cb + 2 * lane;
        float acc[9][2];
#pragma unroll
        for (int r = 0; r < 9; ++r) { acc[r][0] = 0.f; acc[r][1] = 0.f; }
        const int kbeg = wid * 128;
#pragma unroll 4
        for (int k = kbeg; k < kbeg + 128; ++k) {
            const float2 wv = *(const float2*)(w + (size_t)k * MODW);
#pragma unroll
            for (int r = 0; r < 9; ++r) { const float sv = S[r * D + k]; acc[r][0] += sv * wv.x; acc[r][1] += sv * wv.y; }
        }
#pragma unroll
        for (int r = 0; r < 9; ++r) { RED[(wid * 9 + r) * 128 + 2 * lane] = acc[r][0]; RED[(wid * 9 + r) * 128 + 2 * lane + 1] = acc[r][1]; }
        __syncthreads();
        for (int i = tid; i < 9 * 128; i += 512) { const int r = i >> 7, cc = i & 127; float s = a.in[5][layer * MODW + cb + cc];
#pragma unroll
            for (int w8 = 0; w8 < 8; ++w8) s += RED[(w8 * 9 + r) * 128 + cc];
            MOD[(size_t)(layer * 9 + r) * MODW + cb + cc] = s; }
        __syncthreads();
    }
    for (int i = I.gt; i < T * (D / 4); i += I.ngt) {
        const int row = i >> 8, c4 = i & 255; const int b = row / TPB, t = row - b * TPB;
        const f32x4* src = (t < SEQ) ? (const f32x4*)(a.in[0] + ((size_t)(b * SEQ + t)) * D) : (const f32x4*)(a.in[2] + ((size_t)(b * CTX + (t - SEQ))) * D);
        ((f32x4*)(X + (size_t)row * D))[c4] = src[c4];
    }
    LAS float* scr = (LAS float*)(lds + wid * 8704);
    constexpr int I_IN = (D / 64) * (2 * DFF / 32)  , I_OUT = (DFF / 64) * (D / 32)  ;
    constexpr int I_QKV3 = 16 * 96, I_O = 16 * 32, I_QKVB = 16 * 48, I_DOWN = 16 * 13, I_UQ = 4 * 48, I_UKV = 2 * 64;
    constexpr int NITEMS = 8 * I_IN + 8 * I_OUT + 2 * I_QKV3 + 4 * I_O + I_QKVB + I_DOWN + I_UQ + I_UKV;
    for (int it = I.gw; it < NITEMS; it += I.ngw) {
        int r = it;
        if (r < 8 * I_IN) { const int q = r / I_IN, item = r % I_IN; const int nblk = 2 * DFF / 32, kb = item / nblk, nb = item % nblk; const int n0 = 32 * nb;
            const int j = (n0 < DFF) ? n0 : n0 - DFF; const int dst = (j / 128) * 256 + (j % 128) + ((n0 < DFF) ? 0 : 128);
            transpose_item(a.in[7] + (size_t)q * D * 2 * DFF, D, 2 * DFF, WIN + (size_t)q * 2 * DFF * D, 64 * kb, n0, dst, scr, lane); continue; }
        r -= 8 * I_IN;
        if (r < 8 * I_OUT) { const int q = r / I_OUT, item = r % I_OUT; conv_item_plain(a.in[8] + (size_t)q * DFF * D, DFF, D, WOUT + (size_t)q * D * DFF, item, scr, lane); continue; }
        r -= 8 * I_OUT;
        if (r < I_QKV3) { conv_item_plain(a.in[9], D, 3072, (bf16_t*)(ws + WS_WA_QKV), r, scr, lane); continue; } r -= I_QKV3;
        if (r < I_O) { conv_item_plain(a.in[15], D, D, (bf16_t*)(ws + WS_WA_O), r, scr, lane); continue; } r -= I_O;
        if (r < I_QKVB) { conv_item_plain(a.in[16], D, 1536, (bf16_t*)(ws + WS_WB_QKV), r, scr, lane); continue; } r -= I_QKVB;
        if (r < I_O) { conv_item_plain(a.in[19], D, D, (bf16_t*)(ws + WS_WB_O), r, scr, lane); continue; } r -= I_O;
        if (r < I_DOWN) { conv_item_plain(a.in[20], D, 416, (bf16_t*)(ws + WS_WC_DOWN), r, scr, lane); continue; } r -= I_DOWN;
        if (r < I_UQ) { conv_item_plain(a.in[23], 256, 1536, (bf16_t*)(ws + WS_WC_UQ), r, scr, lane); continue; } r -= I_UQ;
        if (r < I_UKV) { conv_item_plain(a.in[24], 128, 2048, (bf16_t*)(ws + WS_WC_UKV), r, scr, lane); continue; } r -= I_UKV;
        if (r < I_O) { conv_item_plain(a.in[25], D, D, (bf16_t*)(ws + WS_WC_O), r, scr, lane); continue; } r -= I_O;
        if (r < I_QKV3) { conv_item_plain(a.in[26], D, 3072, (bf16_t*)(ws + WS_WD_QKV), r, scr, lane); continue; } r -= I_QKV3;
        conv_item_plain(a.in[28], D, D, (bf16_t*)(ws + WS_WD_O), r, scr, lane);
    }
    { u32x4* z = (u32x4*)((bf16_t*)(ws + WS_WC_DOWN) + (size_t)416 * D); for (int i = I.gt; i < 96 * D / 8; i += I.ngt) z[i] = (u32x4){0u, 0u, 0u, 0u}; }
}

__device__ __forceinline__ void ph_norm(int layer, int which) { GET_ARGS;
    const Ids I = make_ids();
    const float* modl = (const float*)(a.ws + WS_MOD) + (size_t)layer * 9 * MODW;
    norm_phase((const float*)(a.ws + WS_X), a.in[6] + (layer * 3 + which) * D, modl, which * 3, which * 3 + 1, (bf16_t*)(a.ws + WS_H), I.gw, I.ngw, I.lane);
}
__device__ __forceinline__ void ph_ffn1(LAS unsigned char* lds, int layer, int half, int lat) { GET_ARGS;
    pg8::Gemm g{(const bf16_t*)(a.ws + WS_H), (const bf16_t*)(a.ws + WS_WIN) + (size_t)(layer * 2 + half) * 2 * DFF * D, T, 2 * DFF, D};
    const Ids I = make_ids(); pg8::PanelOrder S; S.init(2 * DFF, I.G, I.bx, lat);
    pg8::EpiSwiGLU E{(bf16_t*)(a.ws + WS_ACT), DFF};
    pg8::gemm_phase<pg8::EpiSwiGLU, pg8::PanelOrder, true, true>(lds, g, S, E);
}
__device__ __forceinline__ void ph_resid(LAS unsigned char* lds, int layer, int half, int kind, int lat) { GET_ARGS;
    const float* modl = (const float*)(a.ws + WS_MOD) + (size_t)layer * 9 * MODW;
    pg8::Gemm g; const float* gate; float gs;
    if (kind == 0) { g = pg8::Gemm{(const bf16_t*)(a.ws + WS_ACT), (const bf16_t*)(a.ws + WS_WOUT) + (size_t)(layer * 2 + half) * D * DFF, T, D, DFF}; gate = modl + (half * 6 + 2) * D; gs = 0.5f; }
    else { const size_t wo = (layer == 0) ? WS_WA_O : (layer == 1) ? WS_WB_O : (layer == 2) ? WS_WC_O : WS_WD_O;
        g = pg8::Gemm{(const bf16_t*)(a.ws + WS_O), (const bf16_t*)(a.ws + wo), T, D, D}; gate = modl + 5 * D; gs = 1.0f; }
    const Ids I = make_ids(); pg8::PanelOrder S; S.init(D, I.G, I.bx, lat);
    pg8::EpiResid E{(float*)(a.ws + WS_X), gate, gs};
    pg8::gemm_phase<pg8::EpiResid, pg8::PanelOrder, true, true>(lds, g, S, E);
}
__device__ __forceinline__ void ph_probe_ffn2(LAS unsigned char* lds, int layer, int half) { GET_ARGS;
    pg8::Gemm g{(const bf16_t*)(a.ws + WS_ACT), (const bf16_t*)(a.ws + WS_WOUT) + (size_t)(layer * 2 + half) * D * DFF, T, D, DFF};
    const Ids I = make_ids(); pg8::StaticOrder S; S.init(T, D, I.G, I.bx);
    pg8::EpiStore E{(bf16_t*)(a.ws + WS_QKV), D};
    pg8::gemm_phase<pg8::EpiStore, pg8::StaticOrder, true, true>(lds, g, S, E);
}
__device__ __forceinline__ void ph_proj(LAS unsigned char* lds, int layer, int step) { GET_ARGS;
    unsigned char* ws = a.ws; const bf16_t* H = (const bf16_t*)(ws + WS_H); bf16_t* QKV = (bf16_t*)(ws + WS_QKV);
    pg8::Gemm gd[2]; bf16_t* outp[2]; int ldo[2]; int ng = 1;
    if (layer == 0) { gd[0] = pg8::Gemm{H, (const bf16_t*)(ws + WS_WA_QKV), T, 3072, D}; outp[0] = QKV; ldo[0] = 3072; }
    else if (layer == 1) { gd[0] = pg8::Gemm{H, (const bf16_t*)(ws + WS_WB_QKV), T, 1536, D}; outp[0] = QKV; ldo[0] = 1536; }
    else if (layer == 3) { gd[0] = pg8::Gemm{H, (const bf16_t*)(ws + WS_WD_QKV), T, 3072, D}; outp[0] = QKV; ldo[0] = 3072; }
    else if (step == 0) { gd[0] = pg8::Gemm{H, (const bf16_t*)(ws + WS_WC_DOWN), T, 512, D}; outp[0] = (bf16_t*)(ws + WS_DOWN); ldo[0] = 512; }
    else { gd[0] = pg8::Gemm{(const bf16_t*)(ws + WS_CQN), (const bf16_t*)(ws + WS_WC_UQ), T, 1536, 256}; outp[0] = (bf16_t*)(ws + WS_QM); ldo[0] = 1536;
           gd[1] = pg8::Gemm{(const bf16_t*)(ws + WS_CKVN), (const bf16_t*)(ws + WS_WC_UKV), T, 2048, 128}; outp[1] = (bf16_t*)(ws + WS_KVM); ldo[1] = 2048; ng = 2; }
    if (ng == 1) { gd[1] = gd[0]; outp[1] = outp[0]; ldo[1] = ldo[0]; }
    const pg8::Gemm g0 = gd[0], g1 = gd[1]; bf16_t* const o0 = outp[0]; bf16_t* const o1 = outp[1]; const int l0 = ldo[0], l1 = ldo[1];
    for (int gi = 0; gi < ng; ++gi) {
        pg8::Gemm gg; gg.A = gi ? g1.A : g0.A; gg.Bt = gi ? g1.Bt : g0.Bt; gg.M = T; gg.N = gi ? g1.N : g0.N; gg.K = gi ? g1.K : g0.K;
        const Ids I = make_ids(); pg8::StaticOrder S; S.init(T, gg.N, I.G, I.bx);
        pg8::EpiStore E{gi ? o1 : o0, gi ? l1 : l0};
        pg8::gemm_phase<pg8::EpiStore, pg8::StaticOrder, true, true>(lds, gg, S, E);
    }
}
template <int LS> __device__ __forceinline__ void ph_post() { GET_ARGS;
    const Ids I = make_ids(); const int lane = I.lane; unsigned char* ws = a.ws; bf16_t* QKV = (bf16_t*)(ws + WS_QKV);
    if (LS == 0) {
        for (int i = I.gt; i < NB * SEQ * 256; i += I.ngt) {
            const int e = i & 7, vec = (i >> 3) & 31, lrow = i >> 8; const int b = lrow >> 11, t = lrow & 2047;
            const int hf = e >> 2, jq = e & 3, pos = hf ? (t & 63) : (t >> 6);
            bf16_t* p1 = QKV + ((size_t)b * TPB + t) * 3072 + vec * 64 + hf * 32 + 4 * jq;
            const u32x2 w1 = *(const u32x2*)p1, w2 = *(const u32x2*)(p1 + 16);
            const float x1[4] = {bf_lo(w1.x), bf_hi(w1.x), bf_lo(w1.y), bf_hi(w1.y)}, x2[4] = {bf_lo(w2.x), bf_hi(w2.x), bf_lo(w2.y), bf_hi(w2.y)};
            float o1[4], o2[4];
#pragma unroll
            for (int q = 0; q < 4; ++q) { float c, s; rope_cs(pos, 4 * jq + q, L2T / 16.0f, c, s); o1[q] = x1[q] * c - x2[q] * s; o2[q] = x1[q] * s + x2[q] * c; }
            u32x2 r1, r2; r1.x = pk2(o1[0], o1[1]); r1.y = pk2(o1[2], o1[3]); r2.x = pk2(o2[0], o2[1]); r2.y = pk2(o2[2], o2[3]);
            *(u32x2*)p1 = r1; *(u32x2*)(p1 + 16) = r2;
        }
    } else if (LS == 2) {
        for (int i = I.gt; i < T * 20 * 8; i += I.ngt) {
            const int e = i & 7, rest = i >> 3, vec = rest % 20, row = rest / 20; const int b = row / TPB, t = row - b * TPB;
            const int hf = e >> 2, jq = e & 3, pos = hf ? (t & 63) : (t >> 6);
            bf16_t* p1 = QKV + (size_t)row * 1536 + vec * 64 + hf * 32 + 4 * jq;
            const u32x2 w1 = *(const u32x2*)p1, w2 = *(const u32x2*)(p1 + 16);
            float x1[4] = {bf_lo(w1.x), bf_hi(w1.x), bf_lo(w1.y), bf_hi(w1.y)}, x2[4] = {bf_lo(w2.x), bf_hi(w2.x), bf_lo(w2.y), bf_hi(w2.y)};
            float ss = 0.f;
#pragma unroll
            for (int q = 0; q < 4; ++q) ss += x1[q] * x1[q] + x2[q] * x2[q];
            ss += __shfl_xor(ss, 1); ss += __shfl_xor(ss, 2); ss += __shfl_xor(ss, 4);
            const float rn = 1.0f / sqrtf(ss * (1.0f / 64.0f) + EPS);
            const float* gg = ((vec < 16) ? a.in[17] : a.in[18]) + hf * 32 + 4 * jq;
            float o1[4], o2[4];
#pragma unroll
            for (int q = 0; q < 4; ++q) { x1[q] = x1[q] * rn * gg[q]; x2[q] = x2[q] * rn * gg[16 + q]; }
            if (t < SEQ) {
#pragma unroll
                for (int q = 0; q < 4; ++q) { float c, s; rope_cs(pos, 4 * jq + q, L2T / 16.0f, c, s); o1[q] = x1[q] * c - x2[q] * s; o2[q] = x1[q] * s + x2[q] * c; }
            } else {
#pragma unroll
                for (int q = 0; q < 4; ++q) { o1[q] = x1[q]; o2[q] = x2[q]; }
            }
            u32x2 r1, r2; r1.x = pk2(o1[0], o1[1]); r1.y = pk2(o1[2], o1[3]); r2.x = pk2(o2[0], o2[1]); r2.y = pk2(o2[2], o2[3]);
            *(u32x2*)p1 = r1; *(u32x2*)(p1 + 16) = r2;
        }
    } else if (LS == 4) {
        const bf16_t* DOWN = (const bf16_t*)(ws + WS_DOWN);
        bf16_t* CQN = (bf16_t*)(ws + WS_CQN); bf16_t* CKVN = (bf16_t*)(ws + WS_CKVN); bf16_t* KPE = (bf16_t*)(ws + WS_KPE);
        for (int row = I.gw; row < T; row += I.ngw) {
            const int b = row / TPB, t = row - b * TPB;
            const bf16_t* dr = DOWN + (size_t)row * 512;
            const u32x2 wq = *(const u32x2*)(dr + 4 * lane);
            const float q4[4] = {bf_lo(wq.x), bf_hi(wq.x), bf_lo(wq.y), bf_hi(wq.y)};
            const float rq = 1.0f / sqrtf(wave_sum(q4[0] * q4[0] + q4[1] * q4[1] + q4[2] * q4[2] + q4[3] * q4[3]) * (1.0f / 256.0f) + EPS);
            const f32x4 gq = *(const f32x4*)(a.in[21] + 4 * lane);
            u32x2 oq; oq.x = pk2(q4[0] * rq * gq.x, q4[1] * rq * gq.y); oq.y = pk2(q4[2] * rq * gq.z, q4[3] * rq * gq.w);
            *(u32x2*)(CQN + (size_t)row * 256 + 4 * lane) = oq;
            const unsigned wk = *(const unsigned*)(dr + 256 + 2 * lane);
            const float k0 = bf_lo(wk), k1 = bf_hi(wk);
            const float rk = 1.0f / sqrtf(wave_sum(k0 * k0 + k1 * k1) * (1.0f / 128.0f) + EPS);
            *(unsigned*)(CKVN + (size_t)row * 128 + 2 * lane) = pk2(k0 * rk * a.in[22][2 * lane], k1 * rk * a.in[22][2 * lane + 1]);
            if (lane < 4) {
                const int hf = lane >> 1, jq = lane & 1, pos = hf ? (t & 63) : (t >> 6);
                const bf16_t* p1 = dr + 384 + hf * 16 + 4 * jq;
                const u32x2 w1 = *(const u32x2*)p1, w2 = *(const u32x2*)(p1 + 8);
                const float x1[4] = {bf_lo(w1.x), bf_hi(w1.x), bf_lo(w1.y), bf_hi(w1.y)}, x2[4] = {bf_lo(w2.x), bf_hi(w2.x), bf_lo(w2.y), bf_hi(w2.y)};
                float o1[4], o2[4];
#pragma unroll
                for (int q = 0; q < 4; ++q) { float c = 1.f, s = 0.f; if (t < SEQ) rope_cs(pos, 4 * jq + q, L2T / 8.0f, c, s); o1[q] = x1[q] * c - x2[q] * s; o2[q] = x1[q] * s + x2[q] * c; }
                u32x2 r1, r2; r1.x = pk2(o1[0], o1[1]); r1.y = pk2(o1[2], o1[3]); r2.x = pk2(o2[0], o2[1]); r2.y = pk2(o2[2], o2[3]);
                bf16_t* po = KPE + (size_t)row * 32 + hf * 16 + 4 * jq;
                *(u32x2*)po = r1; *(u32x2*)(po + 8) = r2;
            }
        }
    } else if (LS == 5) {
        bf16_t* QM = (bf16_t*)(ws + WS_QM);
        for (int i = I.gt; i < NB * SEQ * 64; i += I.ngt) {
            const int e = i & 3, h = (i >> 2) & 15, lrow = i >> 6; const int b = lrow >> 11, t = lrow & 2047;
            const int hf = e >> 1, jq = e & 1, pos = hf ? (t & 63) : (t >> 6);
            bf16_t* p1 = QM + ((size_t)b * TPB + t) * 1536 + h * 96 + 64 + hf * 16 + 4 * jq;
            const u32x2 w1 = *(const u32x2*)p1, w2 = *(const u32x2*)(p1 + 8);
            const float x1[4] = {bf_lo(w1.x), bf_hi(w1.x), bf_lo(w1.y), bf_hi(w1.y)}, x2[4] = {bf_lo(w2.x), bf_hi(w2.x), bf_lo(w2.y), bf_hi(w2.y)};
            float o1[4], o2[4];
#pragma unroll
            for (int q = 0; q < 4; ++q) { float c, s; rope_cs(pos, 4 * jq + q, L2T / 8.0f, c, s); o1[q] = x1[q] * c - x2[q] * s; o2[q] = x1[q] * s + x2[q] * c; }
            u32x2 r1, r2; r1.x = pk2(o1[0], o1[1]); r1.y = pk2(o1[2], o1[3]); r2.x = pk2(o2[0], o2[1]); r2.y = pk2(o2[2], o2[3]);
            *(u32x2*)p1 = r1; *(u32x2*)(p1 + 8) = r2;
        }
    }
}
template <int L> __device__ __forceinline__ void ph_attn(LAS unsigned char* lds) { GET_ARGS;
    const Ids I = make_ids(); unsigned char* ws = a.ws; const bf16_t* QKV = (const bf16_t*)(ws + WS_QKV); bf16_t* OB = (bf16_t*)(ws + WS_O);
    if (L == 0) {
        float s1 = 0.f, s2 = 0.f;
        for (int i = 0; i < 64; ++i) { s1 += a.in[10][i] * a.in[11][i]; s2 += a.in[12][i] * a.in[13][i]; }
        const float lam = __expf(s1) - __expf(s2) + 0.2f;
        AttnP P{QKV, QKV, nullptr, QKV, OB, 3072, 3072, 3072, nullptr, lam, a.in[14], 0.125f * LOG2E};
        attn_phase<0>(lds, P, I.vcu, I.G);
    } else if (L == 1) {
        AttnP P{QKV, QKV, nullptr, QKV, OB, 1536, 1536, 1536, nullptr, 0.f, nullptr, 0.125f * LOG2E};
        attn_phase<1>(lds, P, I.vcu, I.G);
    } else if (L == 2) {
        AttnP P{(const bf16_t*)(ws + WS_QM), (const bf16_t*)(ws + WS_KVM), (const bf16_t*)(ws + WS_KPE), (const bf16_t*)(ws + WS_KVM), OB, 1536, 2048, 2048, nullptr, 0.f, nullptr, 0.10206207261596575f * LOG2E};
        attn_phase<2>(lds, P, I.vcu, I.G);
    } else {
        AttnP P{QKV, QKV, nullptr, QKV, OB, 3072, 3072, 3072, a.in[27], 0.f, nullptr, 0.125f * LOG2E};
        attn_phase<3>(lds, P, I.vcu, I.G);
    }
}
__device__ __forceinline__ void ph_final() { GET_ARGS;
    const Ids I = make_ids(); const int lane = I.lane; const float* X = (const float*)(a.ws + WS_X);
    for (int lrow = I.gw; lrow < NB * SEQ; lrow += I.ngw) {
        const int b = lrow >> 11, t = lrow & 2047;
        const f32x4* xr = (const f32x4*)(X + ((size_t)b * TPB + t) * D) + lane;
        f32x4 v[4]; float ss = 0.f;
#pragma unroll
        for (int j = 0; j < 4; ++j) { v[j] = xr[64 * j]; ss += (v[j].x * v[j].x + v[j].y * v[j].y) + (v[j].z * v[j].z + v[j].w * v[j].w); }
        const float r = 1.0f / sqrtf(wave_sum(ss) * (1.0f / D) + EPS);
        f32x4* orow = (f32x4*)(a.out + (size_t)lrow * D) + lane;
#pragma unroll
        for (int j = 0; j < 4; ++j) { const f32x4 gg = *(const f32x4*)(a.in[29] + 4 * (lane + 64 * j)); orow[64 * j] = v[j] * r * gg; }
    }
}

#define DYN_LDS extern __shared__ __attribute__((aligned(16))) unsigned char lds_raw[]; LAS unsigned char* lds = (LAS unsigned char*)lds_raw

#if MEGA
__global__ void __launch_bounds__(512, 2) mega_fwd(Args a) {
    DYN_LDS;
    cg::grid_group grid = cg::this_grid();
    volatile LAS unsigned* misc = (volatile LAS unsigned*)(lds + 131072 + 320);
    if (threadIdx.x < 32) misc[threadIdx.x] = 0u;
    __syncthreads();
    unsigned* barw; { GET_ARGS; barw = (unsigned*)(a.ws + WS_CTL); }
    const XcdBarrier bar = xcd_barrier_post(barw, misc + 8);
#define GSYNC() xcd_barrier(bar)
#ifndef PROBE_DUP
#define PROBE_DUP 0
#endif
    ph_prologue(lds);
    if (PROBE_DUP & 32) { GSYNC(); ph_prologue(lds); }
    grid.sync();
    for (int layer = 0; layer < 4; ++layer) {
        for (int half = 0; half < 2; ++half) {
            ph_norm(layer, half * 2); GSYNC();
            if (PROBE_DUP & 1) { ph_norm(layer, half * 2); GSYNC(); }
            const int lat = (layer == 3 && half == 1) ? 1 : 0;
            ph_ffn1(lds, layer, half, lat); GSYNC();
            if (PROBE_DUP & 16) { ph_probe_ffn2(lds, layer, half); GSYNC(); }
            ph_resid(lds, layer, half, 0, lat); GSYNC();
            if (half == 1) break;
            ph_norm(layer, 1); GSYNC();
            ph_proj(lds, layer, 0); GSYNC();
            if (PROBE_DUP & 8) { ph_proj(lds, layer, 0); GSYNC(); }
            if (layer == 0) { ph_post<0>(); GSYNC(); ph_attn<0>(lds); if (PROBE_DUP & 4) { GSYNC(); ph_attn<0>(lds); } }
            else if (layer == 1) { ph_post<2>(); GSYNC(); ph_attn<1>(lds); if (PROBE_DUP & 4) { GSYNC(); ph_attn<1>(lds); } }
            else if (layer == 2) { ph_post<4>(); GSYNC(); ph_proj(lds, layer, 1); GSYNC(); ph_post<5>(); GSYNC(); ph_attn<2>(lds); if (PROBE_DUP & 4) { GSYNC(); ph_attn<2>(lds); } }
            else { ph_attn<3>(lds); if (PROBE_DUP & 4) { GSYNC(); ph_attn<3>(lds); } }
            GSYNC();
            ph_resid(lds, layer, 0, 1, (layer == 3) ? 1 : 0); GSYNC();
        }
    }
    ph_final();
}
#else
__global__ void __launch_bounds__(512, 2) k_pro(Args a) { DYN_LDS; ph_prologue(lds); }
__global__ void __launch_bounds__(512, 2) k_norm(Args a, int layer, int which) { ph_norm(layer, which); }
__global__ void __launch_bounds__(512, 2) k_ffn1(Args a, int layer, int half) { DYN_LDS; ph_ffn1(lds, layer, half); }
__global__ void __launch_bounds__(512, 2) k_resid(Args a, int layer, int half, int kind) { DYN_LDS; ph_resid(lds, layer, half, kind); }
__global__ void __launch_bounds__(512, 2) k_proj(Args a, int layer, int step) { DYN_LDS; ph_proj(lds, layer, step); }
template <int LS> __global__ void __launch_bounds__(512, 2) k_post(Args a) { ph_post<LS>(); }
template <int L> __global__ void __launch_bounds__(512, 2) k_attn(Args a) { DYN_LDS; ph_attn<L>(lds); }
__global__ void __launch_bounds__(512, 2) k_final(Args a) { ph_final(); }
#endif

extern "C" void kernel_launch(void* const* d_in, const int* in_sizes, int n_in, void* d_out, int out_size, void* d_ws, size_t ws_size, hipStream_t stream) {
    static int grid = 0;
    if (grid == 0) {
        if (n_in != 30 || ws_size < WS_END) { fprintf(stderr, "kernel_launch: bad inputs n_in %d ws %zu need %zu\n", n_in, ws_size, (size_t)WS_END); grid = -1; return; }
        int dev = 0, cus = 0;
        (void)hipGetDevice(&dev);
        (void)hipDeviceGetAttribute(&cus, hipDeviceAttributeMultiprocessorCount, dev);
#if MEGA
        int per_cu = 0;
        if (hipFuncSetAttribute((const void*)mega_fwd, hipFuncAttributeMaxDynamicSharedMemorySize, LDS_BYTES) != hipSuccess) fprintf(stderr, "kernel_launch: hipFuncSetAttribute failed\n");
        if (hipOccupancyMaxActiveBlocksPerMultiprocessor(&per_cu, (const void*)mega_fwd, 512, LDS_BYTES) != hipSuccess || per_cu < 1) { fprintf(stderr, "kernel_launch: occupancy query gave %d\n", per_cu); per_cu = 1; }
        (void)hipGetLastError();
        grid = cus * per_cu;
#else
        (void)hipFuncSetAttribute((const void*)k_pro, hipFuncAttributeMaxDynamicSharedMemorySize, LDS_BYTES);
        (void)hipFuncSetAttribute((const void*)k_ffn1, hipFuncAttributeMaxDynamicSharedMemorySize, LDS_BYTES);
        (void)hipFuncSetAttribute((const void*)k_resid, hipFuncAttributeMaxDynamicSharedMemorySize, LDS_BYTES);
        (void)hipFuncSetAttribute((const void*)k_proj, hipFuncAttributeMaxDynamicSharedMemorySize, LDS_BYTES);
        (void)hipFuncSetAttribute((const void*)k_attn<0>, hipFuncAttributeMaxDynamicSharedMemorySize, LDS_BYTES);
        (void)hipFuncSetAttribute((const void*)k_attn<1>, hipFuncAttributeMaxDynamicSharedMemorySize, LDS_BYTES);
        (void)hipFuncSetAttribute((const void*)k_attn<2>, hipFuncAttributeMaxDynamicSharedMemorySize, LDS_BYTES);
        (void)hipFuncSetAttribute((const void*)k_attn<3>, hipFuncAttributeMaxDynamicSharedMemorySize, LDS_BYTES);
        (void)hipGetLastError();
        grid = cus;
#endif
        if (grid <= 0) grid = 256;
    }
    if (grid < 0) return;
    Args a{};
    for (int i = 0; i < 30; ++i) a.in[i] = (const float*)d_in[i];
    a.out = (float*)d_out; a.ws = (unsigned char*)d_ws;
#if MEGA
    (void)hipMemsetAsync((char*)d_ws + WS_CTL, 0, 16384, stream);
    void* args[] = {&a};
    hipError_t e = hipLaunchCooperativeKernel((const void*)mega_fwd, dim3(grid), dim3(512), args, LDS_BYTES, stream);
    if (e != hipSuccess) fprintf(stderr, "kernel_launch: cooperative launch failed: %s (grid %d)\n", hipGetErrorString(e), grid);
#else
    const dim3 g(grid), b(512);
    hipLaunchKernelGGL(k_pro, g, b, LDS_BYTES, stream, a);
    for (int layer = 0; layer < 4; ++layer) {
        for (int half = 0; half < 2; ++half) {
            hipLaunchKernelGGL(k_norm, g, b, 0, stream, a, layer, half * 2);
            hipLaunchKernelGGL(k_ffn1, g, b, LDS_BYTES, stream, a, layer, half);
            hipLaunchKernelGGL(k_resid, g, b, LDS_BYTES, stream, a, layer, half, 0);
            if (half == 1) break;
            hipLaunchKernelGGL(k_norm, g, b, 0, stream, a, layer, 1);
            hipLaunchKernelGGL(k_proj, g, b, LDS_BYTES, stream, a, layer, 0);
            if (layer == 0) { hipLaunchKernelGGL(k_post<0>, g, b, 0, stream, a); hipLaunchKernelGGL(k_attn<0>, g, b, LDS_BYTES, stream, a); }
            else if (layer == 1) { hipLaunchKernelGGL(k_post<2>, g, b, 0, stream, a); hipLaunchKernelGGL(k_attn<1>, g, b, LDS_BYTES, stream, a); }
            else if (layer == 2) { hipLaunchKernelGGL(k_post<4>, g, b, 0, stream, a); hipLaunchKernelGGL(k_proj, g, b, LDS_BYTES, stream, a, layer, 1);
                                   hipLaunchKernelGGL(k_post<5>, g, b, 0, stream, a); hipLaunchKernelGGL(k_attn<2>, g, b, LDS_BYTES, stream, a); }
            else { hipLaunchKernelGGL(k_attn<3>, g, b, LDS_BYTES, stream, a); }
            hipLaunchKernelGGL(k_resid, g, b, LDS_BYTES, stream, a, layer, 0, 1);
        }
    }
    hipLaunchKernelGGL(k_final, g, b, 0, stream, a);
#endif
}
```
